# Optimizing an MI355X kernel written in HIP

```python
import math
import jax, jax.numpy as jnp
from jax import lax
import numpy as np

D_MODEL = 2048
BATCH = 2
SEQ = 8192
DEPTH = 1

F_WIDTH = D_MODEL // 2
F_GROUPS = 8
F_GROUP_DIM = F_WIDTH // F_GROUPS
SSD_WIDTH = D_MODEL
HEAD_DIM = 64
SSD_HEADS = SSD_WIDTH // HEAD_DIM
N_BC_GROUPS = 4
D_STATE = 128
D_CONV = 5
CONV_PAD = D_CONV // 2
CONV_CH = SSD_WIDTH + 2 * N_BC_GROUPS * D_STATE
CHUNK = 128
IN_SIZES = [F_WIDTH, F_WIDTH, SSD_WIDTH, CONV_CH, SSD_HEADS, SSD_HEADS, 2 * D_MODEL]
IN_SPLITS = [int(v) for v in np.cumsum(IN_SIZES)[:-1]]
N_IN = int(sum(IN_SIZES))
NORM_EPS = 1e-5
DEEPNORM_ALPHA = (2.0 * DEPTH) ** 0.25
DEEPNORM_BETA = (8.0 * DEPTH) ** -0.25

kernel_name = "hybrid_fnet_ssd_gated_deepnorm"


def layer_norm(x, g, b):
    xf = x.astype(jnp.float32)
    mu = jnp.mean(xf, axis=-1, keepdims=True)
    var = jnp.mean(jnp.square(xf - mu), axis=-1, keepdims=True)
    y = (xf - mu) * lax.rsqrt(var + NORM_EPS)
    return (y * g.astype(jnp.float32) + b.astype(jnp.float32)).astype(x.dtype)


def gated_rms_norm(y, z, w):
    b, l, d = y.shape
    h = (y * jax.nn.silu(z)).astype(jnp.float32).reshape(b, l, N_BC_GROUPS, d // N_BC_GROUPS)
    h = h * lax.rsqrt(jnp.mean(jnp.square(h), axis=-1, keepdims=True) + NORM_EPS)
    return (h.reshape(b, l, d) * w.astype(jnp.float32)).astype(y.dtype)


def centred_depthwise_conv(u, w, bias):
    c = u.shape[-1]
    out = lax.conv_general_dilated(
        u, w[:, None, :].astype(u.dtype), window_strides=(1,), padding=[(CONV_PAD, CONV_PAD)],
        dimension_numbers=("NWC", "WIO", "NWC"), feature_group_count=c)
    return out + bias


def ssd_scan(xs, dt, A, Bm, Cm):
    b, l, h, p = xs.shape
    g, n = Bm.shape[2], Bm.shape[3]
    r = h // g
    c = l // CHUNK
    xdt = (xs * dt[..., None]).reshape(b, c, CHUNK, g, r, p)
    Bc = Bm.reshape(b, c, CHUNK, g, n)
    Cc = Cm.reshape(b, c, CHUNK, g, n)
    a = (dt * A).reshape(b, c, CHUNK, g, r)
    a_cs = jnp.cumsum(a, axis=2).transpose(0, 1, 3, 4, 2)
    seg = a_cs[..., :, None] - a_cs[..., None, :]
    lower = jnp.tril(jnp.ones((CHUNK, CHUNK), dtype=bool))
    L = jnp.exp(jnp.where(lower, seg, -jnp.inf))
    cb = jnp.einsum('bclgn,bcsgn->bcgls', Cc, Bc)
    y_diag = jnp.einsum('bcgrls,bcsgrp->bclgrp', cb[:, :, :, None] * L, xdt)
    decay_states = jnp.exp(a_cs[..., -1:] - a_cs)
    states = jnp.einsum('bcsgn,bcgrs,bcsgrp->bcgrpn', Bc, decay_states, xdt)
    chunk_decay = jnp.exp(a_cs[..., -1])

    def step(carry, inp):
        st, dec = inp
        return carry * dec[..., None, None] + st, carry

    _, prev = lax.scan(step, jnp.zeros_like(states[:, 0]),
                       (jnp.moveaxis(states, 1, 0), jnp.moveaxis(chunk_decay, 1, 0)))
    prev = jnp.moveaxis(prev, 0, 1)
    y_off = jnp.einsum('bclgn,bcgrpn,bcgrl->bclgrp', Cc, prev, jnp.exp(a_cs))
    return (y_diag + y_off).reshape(b, l, h, p)


def hybrid_layer(x, w_in, b_gate, conv_w, conv_b, dt_bias_fwd, a_log_fwd, dt_bias_bwd, a_log_bwd,
                 d_skip, ssd_norm_w, f_mix_w, f_mix_b, w_branch_f, w_branch_s, w_out, ln_g, ln_b):
    b, l, _ = x.shape
    proj = jnp.einsum('bld,dn->bln', x, w_in)
    u_f, z_f, z_s, xbc, dt_f, dt_b, gates = jnp.split(proj, IN_SPLITS, axis=-1)
    g_f, g_s = jnp.split(jax.nn.sigmoid(gates + b_gate), 2, axis=-1)

    uf = u_f.reshape(b, l, F_GROUPS, F_GROUP_DIM).astype(jnp.float32)
    four = jnp.fft.fft2(uf, axes=(1, 3), norm="ortho").real.astype(x.dtype)
    mixed = jnp.einsum('blgi,gio->blgo', four, f_mix_w).reshape(b, l, F_WIDTH) + f_mix_b
    p_f = jnp.einsum('blf,fd->bld', mixed * jax.nn.silu(z_f), w_branch_f)

    xbc = jax.nn.silu(centred_depthwise_conv(xbc, conv_w, conv_b))
    xs, Bm, Cm = jnp.split(xbc, [SSD_WIDTH, SSD_WIDTH + N_BC_GROUPS * D_STATE], axis=-1)
    xs = xs.reshape(b, l, SSD_HEADS, HEAD_DIM)
    Bm = Bm.reshape(b, l, N_BC_GROUPS, D_STATE)
    Cm = Cm.reshape(b, l, N_BC_GROUPS, D_STATE)
    dtf = jax.nn.softplus(dt_f.astype(jnp.float32) + dt_bias_fwd.astype(jnp.float32))
    dtb = jax.nn.softplus(dt_b.astype(jnp.float32) + dt_bias_bwd.astype(jnp.float32))
    A_f = -jnp.exp(a_log_fwd.astype(jnp.float32))
    A_b = -jnp.exp(a_log_bwd.astype(jnp.float32))
    y_fwd = ssd_scan(xs, dtf, A_f, Bm, Cm)
    flip = lambda t: jnp.flip(t, axis=1)
    y_bwd = flip(ssd_scan(flip(xs), flip(dtb), A_b, flip(Bm), flip(Cm)))
    y = (y_fwd + y_bwd + xs * d_skip[:, None]).reshape(b, l, SSD_WIDTH).astype(x.dtype)
    y = gated_rms_norm(y, z_s, ssd_norm_w)
    p_s = jnp.einsum('bls,sd->bld', y, w_branch_s)

    out = jnp.einsum('bld,de->ble', g_f * p_f + g_s * p_s, w_out)
    return layer_norm(DEEPNORM_ALPHA * x + out, ln_g, ln_b)


def setup_inputs(seed: int = 0) -> dict:
    key = jax.random.key(seed)
    ks = jax.random.split(key, 18)
    f32 = jnp.float32
    nrm = lambda k, s, sc: jax.random.normal(k, s, f32) * sc

    def dt_bias(k):
        u = jax.random.uniform(k, (DEPTH, SSD_HEADS), f32)
        dt = jnp.exp(u * (math.log(0.1) - math.log(0.001)) + math.log(0.001))
        return dt + jnp.log(-jnp.expm1(-dt))

    def a_log(k):
        return jnp.log(jax.random.uniform(k, (DEPTH, SSD_HEADS), f32, 1.0, 16.0))

    return {
        "x": nrm(ks[0], (BATCH, SEQ, D_MODEL), 1.0),
        "w_in": nrm(ks[1], (DEPTH, D_MODEL, N_IN), D_MODEL ** -0.5),
        "b_gate": nrm(ks[2], (DEPTH, 2 * D_MODEL), 0.01),
        "conv_w": nrm(ks[3], (DEPTH, D_CONV, CONV_CH), D_CONV ** -0.5),
        "conv_b": nrm(ks[4], (DEPTH, CONV_CH), 0.01),
        "dt_bias_fwd": dt_bias(ks[5]),
        "a_log_fwd": a_log(ks[6]),
        "dt_bias_bwd": dt_bias(ks[7]),
        "a_log_bwd": a_log(ks[8]),
        "d_skip": 1.0 + nrm(ks[9], (DEPTH, SSD_HEADS), 0.01),
        "ssd_norm_w": 1.0 + nrm(ks[10], (DEPTH, SSD_WIDTH), 0.01),
        "f_mix_w": nrm(ks[11], (DEPTH, F_GROUPS, F_GROUP_DIM, F_GROUP_DIM), F_GROUP_DIM ** -0.5),
        "f_mix_b": nrm(ks[12], (DEPTH, F_WIDTH), 0.01),
        "w_branch_f": nrm(ks[13], (DEPTH, F_WIDTH, D_MODEL), F_WIDTH ** -0.5 * DEEPNORM_BETA),
        "w_branch_s": nrm(ks[14], (DEPTH, SSD_WIDTH, D_MODEL), SSD_WIDTH ** -0.5 * DEEPNORM_BETA),
        "w_out": nrm(ks[15], (DEPTH, D_MODEL, D_MODEL), D_MODEL ** -0.5 * DEEPNORM_BETA),
        "ln_g": 1.0 + nrm(ks[16], (DEPTH, D_MODEL), 0.01),
        "ln_b": nrm(ks[17], (DEPTH, D_MODEL), 0.01),
    }


def reference(x, w_in, b_gate, conv_w, conv_b, dt_bias_fwd, a_log_fwd, dt_bias_bwd, a_log_bwd,
              d_skip, ssd_norm_w, f_mix_w, f_mix_b, w_branch_f, w_branch_s, w_out, ln_g, ln_b):
    for i in range(DEPTH):
        x = hybrid_layer(x, w_in[i], b_gate[i], conv_w[i], conv_b[i], dt_bias_fwd[i], a_log_fwd[i],
                         dt_bias_bwd[i], a_log_bwd[i], d_skip[i], ssd_norm_w[i], f_mix_w[i], f_mix_b[i],
                         w_branch_f[i], w_branch_s[i], w_out[i], ln_g[i], ln_b[i])
    return x
```

```cpp
#include <hip/hip_runtime.h>
#include <cstdio>
#include <cstdint>
namespace pg8 {
#define PG8_LAS __attribute__((address_space(3)))
typedef unsigned short bf16_t;
typedef short bf16x8 __attribute__((ext_vector_type(8)));
typedef float f32x4 __attribute__((ext_vector_type(4)));
typedef unsigned u32x4 __attribute__((ext_vector_type(4)));
constexpr int BM = 256, BK = 64, HALF = 128, HTB = HALF * BK * 2  , STAGE_BYTES = 8 * HTB, NXCD = 8, WGM = 8;

__host__ __device__ __forceinline__ int lds_byte(int r, int c) { const int st = (r >> 4) * 2 + (c >> 5), rr = r & 15, cc = c & 31, ob = rr * 64 + cc * 2; return st * 1024 + (ob ^ (((ob >> 9) & 1) << 5)); }
__host__ __device__ __forceinline__ void stage_rc(int b, int& R, int& C) { const int st = b / 1024, sb = b % 1024, swz = sb ^ (((sb >> 9) & 1) << 5); R = (st >> 1) * 16 + swz / 64; C = (st & 1) * 32 + (swz % 64) / 2; }
__host__ __device__ __forceinline__ int perm32(int rho) { const int n = rho >> 4, i = rho & 15; return 8 * (i >> 2) + 4 * n + (i & 3); }

struct Unit { int pm, pn; };
struct Gemm { const bf16_t* A; const bf16_t* Bt; int M, N, K; };

struct StaticOrder {
    int nM, nN, nwg, G, c;
    __host__ __device__ void init(int M, int N, int G_, int c_) { nM = M / BM; nN = N / BM; nwg = nM * nN; G = G_; c = c_; }
    __host__ __device__ bool next(int i, Unit& u) const {
        const long L = (long)i * G + c; if (L >= nwg) return false;
        int wgid = (int)L; { const int q = nwg / NXCD, r = nwg % NXCD, xcd = wgid % NXCD, off = wgid / NXCD; wgid = (xcd < r ? xcd * (q + 1) : r * (q + 1) + (xcd - r) * q) + off; }
        const int nig = WGM * nN, gid = wgid / nig, fm = gid * WGM, gsz = (nM - fm) < WGM ? (nM - fm) : WGM;
        u.pm = fm + ((wgid % nig) % gsz); u.pn = (wgid % nig) / gsz; return true;
    }
    __device__ __forceinline__ void a_ready(const Unit&) const {}
    __device__ __forceinline__ void done(const Unit&) const {}
};

typedef float cvt_f32x2 __attribute__((ext_vector_type(2))); typedef __bf16 cvt_bf16x2 __attribute__((ext_vector_type(2)));
__device__ __forceinline__ unsigned cvt_pk_bf16(float lo, float hi) { const cvt_f32x2 v = {lo, hi}; const cvt_bf16x2 b = __builtin_convertvector(v, cvt_bf16x2); return __builtin_bit_cast(unsigned, b); }
__device__ __forceinline__ float bflo(unsigned w) { return __builtin_bit_cast(float, w << 16); }
__device__ __forceinline__ float bfhi(unsigned w) { return __builtin_bit_cast(float, w & 0xffff0000u); }
__device__ __forceinline__ float sigm(float v) { return __builtin_amdgcn_rcpf(1.0f + __builtin_amdgcn_exp2f(-1.4426950408889634f * v)); }
__device__ __forceinline__ float silu(float v) { return v * sigm(v); }
__device__ __forceinline__ u32x4 pack8(const f32x4& v0, const f32x4& v1) { u32x4 w; w.x = cvt_pk_bf16(v0[0], v0[1]); w.y = cvt_pk_bf16(v0[2], v0[3]); w.z = cvt_pk_bf16(v1[0], v1[1]); w.w = cvt_pk_bf16(v1[2], v1[3]); return w; }
__device__ __forceinline__ void unpack8(const u32x4& w, f32x4& v0, f32x4& v1) { v0 = (f32x4){bflo(w.x), bfhi(w.x), bflo(w.y), bfhi(w.y)}; v1 = (f32x4){bflo(w.z), bfhi(w.z), bflo(w.w), bfhi(w.w)}; }

struct EpiInProj {
    static constexpr bool PERM = true, AFTER_DRAIN = false;
    bf16_t *ypk, *szf, *szs, *xbc;
    __device__ __forceinline__ void operator()(const f32x4 (&acc)[2][2][4][2], const Unit& u, int wr, int wc, int fr, int fq) const {
        const int pn = u.pn; bf16_t* base; int ldc, colt; bool act;
        if (pn < 4) { base = ypk; ldc = 1024; colt = pn * BM; act = false; }
        else if (pn < 8) { base = szf; ldc = 1024; colt = (pn - 4) * BM; act = true; }
        else if (pn < 16) { base = szs; ldc = 2048; colt = (pn - 8) * BM; act = true; }
        else { base = xbc; ldc = 3072; colt = (pn - 16) * BM; act = false; }
        const int row0 = u.pm * BM + wr * 64 + fr, col0 = colt + wc * 32 + 8 * fq;
#pragma unroll
        for (int ai = 0; ai < 2; ++ai)
#pragma unroll
            for (int m = 0; m < 4; ++m) { bf16_t* rowp = base + (size_t)(row0 + ai * HALF + m * 16) * ldc + col0;
#pragma unroll
                for (int bj = 0; bj < 2; ++bj) { f32x4 v0 = acc[ai][bj][m][0], v1 = acc[ai][bj][m][1];
                    if (act) {
#pragma unroll
                        for (int j = 0; j < 4; ++j) { v0[j] = silu(v0[j]); v1[j] = silu(v1[j]); } }
                    *(u32x4*)(rowp + bj * HALF) = pack8(v0, v1); } }
    }
};
struct EpiGate {
    static constexpr bool PERM = true, AFTER_DRAIN = false;
    bf16_t* S; int ldc; const float* bias;
    __device__ __forceinline__ void operator()(const f32x4 (&acc)[2][2][4][2], const Unit& u, int wr, int wc, int fr, int fq) const {
        const int row0 = u.pm * BM + wr * 64 + fr, col0 = u.pn * BM + wc * 32 + 8 * fq;
        f32x4 bv[2][2];
#pragma unroll
        for (int bj = 0; bj < 2; ++bj)
#pragma unroll
            for (int n = 0; n < 2; ++n) bv[bj][n] = *(const f32x4*)(bias + col0 + bj * HALF + 4 * n);
#pragma unroll
        for (int ai = 0; ai < 2; ++ai)
#pragma unroll
            for (int m = 0; m < 4; ++m) { bf16_t* rowp = S + (size_t)(row0 + ai * HALF + m * 16) * ldc + col0;
#pragma unroll
                for (int bj = 0; bj < 2; ++bj) { f32x4 v0 = acc[ai][bj][m][0] + bv[bj][0], v1 = acc[ai][bj][m][1] + bv[bj][1];
#pragma unroll
                    for (int j = 0; j < 4; ++j) { v0[j] = sigm(v0[j]); v1[j] = sigm(v1[j]); }
                    *(u32x4*)(rowp + bj * HALF) = pack8(v0, v1); } }
    }
};
template <int MODE> struct EpiMul {
    static constexpr bool PERM = true, AFTER_DRAIN = false;
    bf16_t* S1; const bf16_t* S2; bf16_t* O; int ldc;
    __device__ __forceinline__ void operator()(const f32x4 (&acc)[2][2][4][2], const Unit& u, int wr, int wc, int fr, int fq) const {
        const int row0 = u.pm * BM + wr * 64 + fr, col0 = u.pn * BM + wc * 32 + 8 * fq;
#pragma unroll
        for (int ai = 0; ai < 2; ++ai)
#pragma unroll
            for (int m = 0; m < 4; ++m) { const size_t off = (size_t)(row0 + ai * HALF + m * 16) * ldc + col0;
#pragma unroll
                for (int bj = 0; bj < 2; ++bj) {
                    f32x4 a0, a1; unpack8(*(const u32x4*)(S1 + off + bj * HALF), a0, a1);
                    if (MODE == 0) { *(u32x4*)(S1 + off + bj * HALF) = pack8(a0 * acc[ai][bj][m][0], a1 * acc[ai][bj][m][1]); }
                    else { f32x4 g0, g1; unpack8(*(const u32x4*)(S2 + off + bj * HALF), g0, g1);
                           *(u32x4*)(O + off + bj * HALF) = pack8(a0 + g0 * acc[ai][bj][m][0], a1 + g1 * acc[ai][bj][m][1]); } } }
    }
};
struct EpiOut {
    static constexpr bool PERM = false, AFTER_DRAIN = false;
    float* C; const float* X; int ldc; float alpha;
    __device__ __forceinline__ void operator()(const f32x4 (&acc)[2][2][4][2], const Unit& u, int wr, int wc, int fr, int fq) const {
        const int row0 = u.pm * BM + wr * 64 + fr, col0 = u.pn * BM + wc * 32 + 4 * fq;
#pragma unroll
        for (int ai = 0; ai < 2; ++ai)
#pragma unroll
            for (int m = 0; m < 4; ++m) { const size_t off = (size_t)(row0 + ai * HALF + m * 16) * ldc + col0;
#pragma unroll
                for (int bj = 0; bj < 2; ++bj)
#pragma unroll
                    for (int n = 0; n < 2; ++n) { const f32x4 xv = *(const f32x4*)(X + off + bj * HALF + n * 16);
                        *(f32x4*)(C + off + bj * HALF + n * 16) = xv * alpha + acc[ai][bj][m][n]; } }
    }
};
template <class Epi, class Sched, bool ALIGN_EPI = false, bool SP2 = false>
__device__ __forceinline__ void gemm_phase(PG8_LAS unsigned char* lds, const Gemm g, const Sched& S, const Epi& E) {
    const int tid = threadIdx.x, wid = __builtin_amdgcn_readfirstlane(tid >> 6), lane = tid & 63, wr = wid >> 2, wc = wid & 3, fr = lane & 15, fq = lane >> 4;
    const int K = g.K, nt = K / BK;
    unsigned voffA[2], voffB[2];
#pragma unroll
    for (int i = 0; i < 2; ++i) { int R, C; stage_rc(tid * 16 + i * 8192, R, C); const int Rb = Epi::PERM ? ((R & ~31) + perm32(R & 31)) : R;
        voffA[i] = (unsigned)(R * K + C) * 2u; voffB[i] = (unsigned)(Rb * K + C) * 2u; }
    const size_t kstep = (size_t)(BK * 2);
    const size_t hstep = (size_t)HALF * K * 2;
    const size_t tstep = 2 * hstep;
    const unsigned ldsw = (unsigned)wid * 1024u;
    const int aoff = lds_byte(wr * 64 + fr, fq * 8), boff = lds_byte(wc * 32 + fr, fq * 8);
#define PG8_SA(b, h) (((b) * 2 + (h)) * HTB)
#define PG8_SB(b, h) ((4 + (b) * 2 + (h)) * HTB)
#define PG8_STAGE(bufoff, gbase, voff) do { _Pragma("unroll") for (int _i = 0; _i < 2; ++_i) \
        __builtin_amdgcn_global_load_lds((const unsigned*)((const char*)(gbase) + (voff)[_i]), (PG8_LAS unsigned*)(lds + (bufoff) + ldsw + _i * 8192), 16, 0, 0); } while (0)
#define PG8_LDA(dst, b, h) do { _Pragma("unroll") for (int m = 0; m < 4; ++m) _Pragma("unroll") for (int k = 0; k < 2; ++k) dst[m][k] = *(const PG8_LAS bf16x8*)(lds + PG8_SA(b, h) + aoff + m * 2048 + k * 1024); } while (0)
#define PG8_LDB(dst, b, h) do { _Pragma("unroll") for (int n = 0; n < 2; ++n) _Pragma("unroll") for (int k = 0; k < 2; ++k) dst[n][k] = *(const PG8_LAS bf16x8*)(lds + PG8_SB(b, h) + boff + n * 2048 + k * 1024); } while (0)
#define PG8_MMA(ai, bj, At, Bt) do { __builtin_amdgcn_s_setprio(1); _Pragma("unroll") for (int m = 0; m < 4; ++m) _Pragma("unroll") for (int n = 0; n < 2; ++n) _Pragma("unroll") for (int k = 0; k < 2; ++k) \
        acc[ai][bj][m][n] = __builtin_amdgcn_mfma_f32_16x16x32_bf16(Bt[n][k], At[m][k], acc[ai][bj][m][n], 0, 0, 0); __builtin_amdgcn_s_setprio(0); } while (0)
#define PG8_WAIT_V(n) asm volatile("s_waitcnt vmcnt(" #n ")" ::: "memory")
#define PG8_WAIT_L(n) asm volatile("s_waitcnt lgkmcnt(" #n ")" ::: "memory")
#define PG8_BAR __builtin_amdgcn_s_barrier()
#define PG8_SCHED __builtin_amdgcn_sched_barrier(0)
    Unit cur, nxt; int ui = 0;
    if (!S.next(0, cur)) return;
    f32x4 acc[2][2][4][2];
#pragma unroll
    for (int a = 0; a < 2; ++a)
#pragma unroll
        for (int b = 0; b < 2; ++b)
#pragma unroll
            for (int m = 0; m < 4; ++m)
#pragma unroll
                for (int n = 0; n < 2; ++n) acc[a][b][m][n] = (f32x4){0.f, 0.f, 0.f, 0.f};
    bf16x8 At[4][2], B0[2][2], B1[2][2];
    const char* cA = (const char*)g.A + (size_t)cur.pm * tstep; const char* cB = (const char*)g.Bt + (size_t)cur.pn * tstep;
    S.a_ready(cur);
    if constexpr (SP2) {
        PG8_STAGE(PG8_SB(0, 0), cB, voffB); PG8_STAGE(PG8_SB(0, 1), cB + hstep, voffB); PG8_STAGE(PG8_SA(0, 0), cA, voffA); PG8_STAGE(PG8_SA(0, 1), cA + hstep, voffA);
        if (wr == 1) PG8_BAR;
        PG8_WAIT_V(2); PG8_BAR;
        PG8_STAGE(PG8_SB(1, 0), cB + kstep, voffB); PG8_STAGE(PG8_SA(1, 0), cA + kstep, voffA); PG8_STAGE(PG8_SB(1, 1), cB + hstep + kstep, voffB);
        PG8_WAIT_V(6); PG8_BAR;
    } else {
        PG8_STAGE(PG8_SB(0, 0), cB, voffB); PG8_STAGE(PG8_SA(0, 0), cA, voffA); PG8_STAGE(PG8_SB(0, 1), cB + hstep, voffB); PG8_STAGE(PG8_SA(0, 1), cA + hstep, voffA);
        if (wr == 1) PG8_BAR;
        PG8_WAIT_V(4); PG8_BAR;
        PG8_STAGE(PG8_SB(1, 0), cB + kstep, voffB); PG8_STAGE(PG8_SA(1, 0), cA + kstep, voffA); PG8_STAGE(PG8_SB(1, 1), cB + hstep + kstep, voffB);
        PG8_WAIT_V(6); PG8_BAR;
    }
    for (;;) {
        const bool has_next = S.next(ui + 1, nxt);
        const char* nA = has_next ? (const char*)g.A + (size_t)nxt.pm * tstep : cA; const char* nB = has_next ? (const char*)g.Bt + (size_t)nxt.pn * tstep : cB;
        for (int t = 0; t < nt; t += 2) {
            const bool last = (t == nt - 2);
            const char* a1 = cA + (size_t)(t + 1) * kstep;
            const char* a2 = last ? nA : cA + (size_t)(t + 2) * kstep; const char* b2 = last ? nB : cB + (size_t)(t + 2) * kstep;
            const char* a3 = a2 + kstep; const char* b3 = b2 + kstep;
            if (last && has_next) S.a_ready(nxt);
            if constexpr (SP2) {
            PG8_LDB(B0, 0, 0); PG8_LDB(B1, 0, 1); PG8_SCHED; PG8_LDA(At, 0, 0); PG8_STAGE(PG8_SA(1, 1), a1 + hstep, voffA);
            PG8_WAIT_V(8); PG8_WAIT_L(0); PG8_BAR; PG8_MMA(0, 0, At, B0); PG8_MMA(0, 1, At, B1); PG8_BAR; PG8_SCHED;
            PG8_LDA(At, 0, 1); PG8_STAGE(PG8_SB(0, 0), b2, voffB); PG8_STAGE(PG8_SB(0, 1), b2 + hstep, voffB); PG8_STAGE(PG8_SA(0, 0), a2, voffA);
            PG8_WAIT_V(8); PG8_WAIT_L(0); PG8_BAR; PG8_MMA(1, 0, At, B0); PG8_MMA(1, 1, At, B1); PG8_BAR; PG8_SCHED;
            PG8_LDB(B0, 1, 0); PG8_LDB(B1, 1, 1); PG8_SCHED; PG8_LDA(At, 1, 0); PG8_STAGE(PG8_SA(0, 1), a2 + hstep, voffA);
            PG8_WAIT_V(8); PG8_WAIT_L(0); PG8_BAR; PG8_MMA(0, 0, At, B0); PG8_MMA(0, 1, At, B1); PG8_BAR; PG8_SCHED;
            PG8_LDA(At, 1, 1); PG8_STAGE(PG8_SB(1, 0), b3, voffB); PG8_STAGE(PG8_SB(1, 1), b3 + hstep, voffB); PG8_STAGE(PG8_SA(1, 0), a3, voffA);
            PG8_WAIT_V(8); PG8_WAIT_L(0); PG8_BAR; PG8_MMA(1, 0, At, B0); PG8_MMA(1, 1, At, B1); PG8_BAR; PG8_SCHED;
            } else {
            PG8_LDB(B0, 0, 0); PG8_SCHED; PG8_LDA(At, 0, 0); PG8_STAGE(PG8_SA(1, 1), a1 + hstep, voffA);
            PG8_WAIT_L(8); PG8_BAR; PG8_WAIT_L(0); PG8_MMA(0, 0, At, B0); PG8_BAR; PG8_SCHED;
            PG8_LDB(B1, 0, 1); PG8_STAGE(PG8_SB(0, 0), b2, voffB);
            PG8_BAR; PG8_WAIT_L(0); PG8_MMA(0, 1, At, B1); PG8_BAR;
            PG8_LDA(At, 0, 1); PG8_STAGE(PG8_SA(0, 0), a2, voffA);
            PG8_BAR; PG8_WAIT_L(0); PG8_MMA(1, 0, At, B0); PG8_BAR; PG8_SCHED;
            PG8_STAGE(PG8_SB(0, 1), b2 + hstep, voffB);
            PG8_WAIT_V(6); PG8_BAR; PG8_MMA(1, 1, At, B1); PG8_BAR;
            PG8_LDB(B0, 1, 0); PG8_SCHED; PG8_LDA(At, 1, 0); PG8_STAGE(PG8_SA(0, 1), a2 + hstep, voffA);
            PG8_WAIT_L(8); PG8_BAR; PG8_WAIT_L(0); PG8_MMA(0, 0, At, B0); PG8_BAR; PG8_SCHED;
            PG8_LDB(B1, 1, 1); PG8_STAGE(PG8_SB(1, 0), b3, voffB);
            PG8_BAR; PG8_WAIT_L(0); PG8_MMA(0, 1, At, B1); PG8_BAR;
            PG8_LDA(At, 1, 1); PG8_STAGE(PG8_SA(1, 0), a3, voffA);
            PG8_BAR; PG8_WAIT_L(0); PG8_MMA(1, 0, At, B0); PG8_BAR; PG8_SCHED;
            PG8_STAGE(PG8_SB(1, 1), b3 + hstep, voffB);
            PG8_WAIT_V(6); PG8_BAR; PG8_MMA(1, 1, At, B1); PG8_BAR;
            }
        }
        if constexpr (ALIGN_EPI) { if (wr == 0) PG8_BAR; }
        if constexpr (!Epi::AFTER_DRAIN) { E(acc, cur, wr, wc, fr, fq); S.done(cur); }
        if (!has_next) break;
#pragma unroll
        for (int a = 0; a < 2; ++a)
#pragma unroll
            for (int b = 0; b < 2; ++b)
#pragma unroll
                for (int m = 0; m < 4; ++m)
#pragma unroll
                    for (int n = 0; n < 2; ++n) acc[a][b][m][n] = (f32x4){0.f, 0.f, 0.f, 0.f};
        cur = nxt; cA = nA; cB = nB; ++ui;
        if constexpr (ALIGN_EPI) { if (wr == 1) PG8_BAR; }
    }
    PG8_WAIT_V(0);
    if constexpr (!ALIGN_EPI) { if (wr == 0) PG8_BAR; }
    PG8_BAR;
    if constexpr (Epi::AFTER_DRAIN) { E.fused(acc, cur, wr, wc, fr, fq, lds, wid, lane); S.done(cur); }
#undef PG8_SA
#undef PG8_SB
#undef PG8_STAGE
#undef PG8_LDA
#undef PG8_LDB
#undef PG8_MMA
#undef PG8_WAIT_V
#undef PG8_WAIT_L
#undef PG8_BAR
#undef PG8_SCHED
}
}
#define GAS __attribute__((address_space(1)))
#define LAS __attribute__((address_space(3)))
typedef unsigned short bf16;
typedef unsigned v4u __attribute__((ext_vector_type(4)));
typedef float f32x4 __attribute__((ext_vector_type(4)));
typedef short bf16x8 __attribute__((ext_vector_type(8)));
typedef GAS unsigned gu32;
typedef GAS unsigned long long gu64;
#define RLX_AGENT __ATOMIC_RELAXED, __HIP_MEMORY_SCOPE_AGENT
#define LDS_WAIT() asm volatile("s_waitcnt lgkmcnt(0)" ::: "memory")
#define VM_WAIT() asm volatile("s_waitcnt vmcnt(0)" ::: "memory")
__device__ __forceinline__ unsigned long long rt() { return __builtin_amdgcn_s_memrealtime(); }

#define XB_TMO      128
#define XB_XCNT(j)  (256  + 64 * (j))
#define XB_XSUB(j)  (1280 + 64 * (j))
#define XB_XGEN(j)  (2304 + 64 * (j))
#define XB_TOP      3328
#define XB_TOPGEN   3392
#define XCD_BAR_WORDS 3456
#define XB_SPIN_CAP (1u << 18)

__device__ __forceinline__ unsigned xb_ld(unsigned* p)              { return __hip_atomic_load(p, __ATOMIC_RELAXED, __HIP_MEMORY_SCOPE_AGENT); }
__device__ __forceinline__ unsigned xb_add(unsigned* p, unsigned v) { return __hip_atomic_fetch_add(p, v, __ATOMIC_RELAXED, __HIP_MEMORY_SCOPE_AGENT); }
__device__ __forceinline__ unsigned xb_xcc_id() { return (unsigned)__builtin_amdgcn_s_getreg((3 << 11) | 20) & 0xFu; }
#define XB_SPIN(cond, bar) do { unsigned _sp = 0; while (cond) { __builtin_amdgcn_s_sleep(1); \
    if ((++_sp & 255u) == 0u) { if (xb_ld(&(bar)[XB_TMO])) break; if (_sp > XB_SPIN_CAP) { atomicAdd(&(bar)[XB_TMO], 1u); break; } } } } while (0)

struct XcdBarrier {
    unsigned* bar; unsigned x;
    volatile LAS unsigned* st;
};

__device__ __forceinline__ XcdBarrier xcd_barrier_post(unsigned* bar, volatile LAS unsigned* st) {
    XcdBarrier b; b.bar = bar; b.x = xb_xcc_id(); b.st = st;
    if (threadIdx.x == 0) (void)xb_add(&bar[XB_XCNT(b.x)], 1u);
    return b;
}
__device__ __forceinline__ void xcd_barrier_complete(unsigned* bar, unsigned x, unsigned& nloc, unsigned& nx) {
    const unsigned G = gridDim.x * gridDim.y * gridDim.z;
    unsigned sum, cnt, mine, sp = 0u;
    for (;;) {
        sum = 0u; cnt = 0u; mine = 0u;
#pragma unroll
        for (unsigned j = 0; j < 16; ++j) { const unsigned c = xb_ld(&bar[XB_XCNT(j)]); sum += c; cnt += (c > 0u) ? 1u : 0u; mine = (j == x) ? c : mine; }
        if (sum == G) break;
        __builtin_amdgcn_s_sleep(1);
        if ((++sp & 255u) == 0u) { if (xb_ld(&bar[XB_TMO])) break; if (sp > XB_SPIN_CAP) { atomicAdd(&bar[XB_TMO], 1u); break; } }
    }
    nloc = mine > 0u ? mine : 1u; nx = cnt > 0u ? cnt : 1u;
}

__device__ __forceinline__ void xcd_barrier(const XcdBarrier& b) {
    asm volatile("s_waitcnt vmcnt(0)" ::: "memory");
    __syncthreads();
    if (threadIdx.x == 0) {
        unsigned* bar = b.bar;
        __builtin_amdgcn_s_waitcnt(0);
        unsigned nloc = b.st[0], nx = b.st[1];
        if (nloc == 0u) { xcd_barrier_complete(bar, b.x, nloc, nx); b.st[0] = nloc; b.st[1] = nx; }
        const unsigned old = xb_add(&bar[XB_XSUB(b.x)], 1u);
        const unsigned gen = old / nloc;
        if (old + 1u == (gen + 1u) * nloc) {
            __builtin_amdgcn_fence(__ATOMIC_RELEASE, "agent");
            asm volatile("s_waitcnt vmcnt(0)" ::: "memory");
            const unsigned og = xb_add(&bar[XB_TOP], 1u);
            const unsigned tg = og / nx;
            if (og + 1u == (tg + 1u) * nx) xb_add(&bar[XB_TOPGEN], 1u);
            else XB_SPIN(xb_ld(&bar[XB_TOPGEN]) == tg, bar);
            __builtin_amdgcn_fence(__ATOMIC_ACQUIRE, "agent");
            xb_add(&bar[XB_XGEN(b.x)], 1u);
            asm volatile("s_waitcnt vmcnt(0)" ::: "memory");
        } else {
            XB_SPIN(xb_ld(&bar[XB_XGEN(b.x)]) == gen, bar);
            __builtin_amdgcn_fence(__ATOMIC_ACQUIRE, "agent");
            asm volatile("s_waitcnt vmcnt(0)" ::: "memory");
        }
    }
    __syncthreads();
}
constexpr int NWAVES = 8;
constexpr int BATCH = 2, SEQ = 8192, DM = 2048, M = BATCH * SEQ;
constexpr int FW = 1024, SW = 2048, NHEAD = 32, CONVCH = 3072, CHUNK = 128, NCHUNK = SEQ / CHUNK;
constexpr int N_IN = 11328, N_P1 = 7168;
constexpr int COL_DT = 7168, COL_GATE = 7232;
constexpr float LN_EPS = 1e-5f, LOG2E = 1.4426950408889634f;
constexpr float DN_ALPHA = 1.189207115002721f;

constexpr size_t MiB = 1u << 20;
constexpr size_t WS_CTL = 0, CTL_ZERO_BYTES = 1 * MiB;
constexpr size_t WS_TW = 1 * MiB;
constexpr size_t WS_F1C = WS_TW + 65536;
constexpr size_t WS_F1S = WS_F1C + 8192;
constexpr size_t WS_W3 = WS_F1S + 8192;
constexpr size_t WS_DEC = WS_W3 + 65536;
constexpr size_t WS_WMIX = WS_DEC + 32768;
constexpr size_t WS_WIN = 2 * MiB;
constexpr size_t WS_WBF = 47 * MiB;
constexpr size_t WS_WBS = 51 * MiB;
constexpr size_t WS_WOUT = 59 * MiB;
constexpr size_t WS_XB = 68 * MiB;
constexpr size_t WS_YPK = 132 * MiB;
constexpr size_t WS_SZF = 164 * MiB;
constexpr size_t WS_SZS = 196 * MiB;
constexpr size_t WS_XBC = 260 * MiB;
constexpr size_t WS_DT = 356 * MiB;
constexpr size_t WS_TP = 360 * MiB;
constexpr size_t WS_END = 424 * MiB;
static_assert(WS_WMIX + 262144 <= WS_WIN && WS_WIN + (size_t)N_IN * DM * 2 <= WS_WBF, "ws map");
constexpr int CW_BAR = 4096;

constexpr int LDS_BYTES = 163840;
constexpr int MISC_OFF = LDS_BYTES - 256;

typedef short s16x4 __attribute__((ext_vector_type(4)));
typedef unsigned v2u __attribute__((ext_vector_type(2)));
typedef float f32x2 __attribute__((ext_vector_type(2)));
#define MFMA16(a, b, c) __builtin_amdgcn_mfma_f32_16x16x32_bf16((a), (b), (c), 0, 0, 0)
__device__ __forceinline__ unsigned pk2(float lo, float hi) { return pg8::cvt_pk_bf16(lo, hi); }
__device__ __forceinline__ float bflo(unsigned w) { return __builtin_bit_cast(float, w << 16); }
__device__ __forceinline__ float bfhi(unsigned w) { return __builtin_bit_cast(float, w & 0xffff0000u); }
__device__ __forceinline__ float ex2(float v) { return __builtin_amdgcn_exp2f(v); }
__device__ __forceinline__ s16x4 trread(const LAS unsigned char* p) { return __builtin_bit_cast(s16x4, __builtin_amdgcn_ds_read_tr16_b64_v4i16((LAS s16x4*)p)); }
__device__ __forceinline__ bf16x8 frag_tr(const LAS unsigned char* img, int rs, int klo, int khi, int c0, int fr) {
    const int off = (fr >> 2) * rs + (c0 + 4 * (fr & 3)) * 2;
    const s16x4 lo = trread(img + klo * rs + off), hi = trread(img + khi * rs + off);
    return (bf16x8){lo[0], lo[1], lo[2], lo[3], hi[0], hi[1], hi[2], hi[3]};
}
__device__ __forceinline__ bf16x8 mk8(unsigned a, unsigned b, unsigned c, unsigned d) { return __builtin_bit_cast(bf16x8, (v4u){a, b, c, d}); }
__device__ __forceinline__ float wave_sum(float v) {
#pragma unroll
    for (int o = 1; o < 64; o <<= 1) v += __shfl_xor(v, o);
    return v;
}
__device__ __forceinline__ float wave_incl_scan(float v, int lane) {
#pragma unroll
    for (int o = 1; o < 64; o <<= 1) { const float t = __shfl_up(v, o); if (lane >= o) v += t; }
    return v;
}

struct Frame {
    LAS unsigned char* lds;
    volatile LAS unsigned* MISC;
    gu32* ctl;
    int tid, lane, wave, bid, G;
    const float* const* in;
    float* out; unsigned char* ws;
    __device__ __forceinline__ const float* x() const { return in[0]; }
    __device__ __forceinline__ const float* w_in() const { return in[1]; }
    __device__ __forceinline__ const float* b_gate() const { return in[2]; }
    __device__ __forceinline__ const float* conv_w() const { return in[3]; }
    __device__ __forceinline__ const float* conv_b() const { return in[4]; }
    __device__ __forceinline__ const float* dtb_f() const { return in[5]; }
    __device__ __forceinline__ const float* alog_f() const { return in[6]; }
    __device__ __forceinline__ const float* dtb_b() const { return in[7]; }
    __device__ __forceinline__ const float* alog_b() const { return in[8]; }
    __device__ __forceinline__ const float* d_skip() const { return in[9]; }
    __device__ __forceinline__ const float* norm_w() const { return in[10]; }
    __device__ __forceinline__ const float* fmix_w() const { return in[11]; }
    __device__ __forceinline__ const float* fmix_b() const { return in[12]; }
    __device__ __forceinline__ const float* w_bf() const { return in[13]; }
    __device__ __forceinline__ const float* w_bs() const { return in[14]; }
    __device__ __forceinline__ const float* w_out() const { return in[15]; }
    __device__ __forceinline__ const float* ln_g() const { return in[16]; }
    __device__ __forceinline__ const float* ln_b() const { return in[17]; }
    __device__ __forceinline__ float2* TW() const { return (float2*)(ws + WS_TW); }
    __device__ __forceinline__ bf16* F1C() const { return (bf16*)(ws + WS_F1C); }
    __device__ __forceinline__ bf16* F1S() const { return (bf16*)(ws + WS_F1S); }
    __device__ __forceinline__ bf16* W3() const { return (bf16*)(ws + WS_W3); }
    __device__ __forceinline__ bf16* WMIX() const { return (bf16*)(ws + WS_WMIX); }
    __device__ __forceinline__ float* DEC() const { return (float*)(ws + WS_DEC); }
    __device__ __forceinline__ bf16* WIN() const { return (bf16*)(ws + WS_WIN); }
    __device__ __forceinline__ bf16* WBF() const { return (bf16*)(ws + WS_WBF); }
    __device__ __forceinline__ bf16* WBS() const { return (bf16*)(ws + WS_WBS); }
    __device__ __forceinline__ bf16* WOUT() const { return (bf16*)(ws + WS_WOUT); }
    __device__ __forceinline__ bf16* XB() const { return (bf16*)(ws + WS_XB); }
    __device__ __forceinline__ bf16* YPK() const { return (bf16*)(ws + WS_YPK); }
    __device__ __forceinline__ bf16* SZF() const { return (bf16*)(ws + WS_SZF); }
    __device__ __forceinline__ bf16* SZS() const { return (bf16*)(ws + WS_SZS); }
    __device__ __forceinline__ bf16* XBC() const { return (bf16*)(ws + WS_XBC); }
    __device__ __forceinline__ bf16* TP() const { return (bf16*)(ws + WS_TP); }
    __device__ __forceinline__ float* DT() const { return (float*)(ws + WS_DT); }
    __device__ __forceinline__ bf16* ST() const { return (bf16*)out; }
};

__device__ __forceinline__ void p0_transpose_item(const float* W, int K, int N, bf16* WT, LAS float* scr, int kb, int nb, int lane) {
    const int k0 = 64 * kb, n0 = 32 * nb;
#pragma unroll 8
    for (int i = 0; i < 32; ++i) { const int kk = 2 * i + (lane >> 5); scr[kk * 33 + (lane & 31)] = W[(size_t)(k0 + kk) * N + n0 + (lane & 31)]; }
    LDS_WAIT(); asm volatile("" ::: "memory");
    const int c = lane & 7;
#pragma unroll
    for (int j = 0; j < 4; ++j) { const int n = (lane >> 3) + 8 * j; const LAS float* s = scr + (8 * c) * 33 + n;
        v4u o; o.x = pk2(s[0 * 33], s[1 * 33]); o.y = pk2(s[2 * 33], s[3 * 33]); o.z = pk2(s[4 * 33], s[5 * 33]); o.w = pk2(s[6 * 33], s[7 * 33]);
        *(v4u*)(WT + (size_t)(n0 + n) * K + k0 + 8 * c) = o; }
    LDS_WAIT(); asm volatile("" ::: "memory");
}
__device__ __forceinline__ void p0_prologue(Frame& F) {
    const int gw = F.bid * NWAVES + F.wave, NGW = F.G * NWAVES, gt = F.bid * 512 + F.tid, NGT = F.G * 512;
    for (int u = gt; u < M * DM / 8; u += NGT) { const f32x4 a = *(const f32x4*)(F.x() + (size_t)u * 8), b = *(const f32x4*)(F.x() + (size_t)u * 8 + 4);
        *(v4u*)(F.XB() + (size_t)u * 8) = (v4u){pk2(a[0], a[1]), pk2(a[2], a[3]), pk2(b[0], b[1]), pk2(b[2], b[3])}; }
    for (int i = gt; i < 8192; i += NGT) { float s, c; sincospif((float)i * (1.0f / 4096.0f), &s, &c); F.TW()[i] = make_float2(c, s); }
    for (int i = gt; i < 4096; i += NGT) { const int ka = i >> 6, na = i & 63; float s, c; sincospif((float)((ka * na) & 63) * (1.0f / 32.0f), &s, &c);
        F.F1C()[i] = (bf16)(pk2(c, 0.f) & 0xffffu); F.F1S()[i] = (bf16)(pk2(-s, 0.f) & 0xffffu); }
    for (int i = gt; i < 128 * 256; i += NGT) { const int kb = i >> 8, k = i & 255, nb = k >> 1, ri = k & 1; float s, c; sincospif((float)((kb * nb) & 127) * (1.0f / 64.0f), &s, &c);
        F.W3()[i] = (bf16)(pk2(ri ? s : c, 0.f) & 0xffffu); }
    for (int i = gt; i < 8 * 128 * 128; i += NGT) { const int c = i & 127, o = (i >> 7) & 127, g = i >> 14; const float* Wg = F.fmix_w() + (size_t)g * 16384;
        float v;
        if (c <= 64) { v = Wg[c * 128 + o]; if (c >= 1 && c <= 63) v += Wg[(128 - c) * 128 + o]; }
        else { const int k2 = c - 64; v = Wg[k2 * 128 + o] - Wg[(128 - k2) * 128 + o]; }
        F.WMIX()[i] = (bf16)(pk2(v, 0.f) & 0xffffu); }
    {
        LAS float* scr = (LAS float*)(F.lds + 65536 + F.wave * 8704);
        constexpr int NB_IN = (N_IN - 1024) / 32;
        constexpr int I_IN = 32 * NB_IN, I_BF = 16 * 64, I_BS = 32 * 64, I_OUT = 32 * 64;
        for (int it = gw; it < I_IN + I_BF + I_BS + I_OUT; it += NGW) {
            int r = it;
            if (r < I_IN) { p0_transpose_item(F.w_in(), DM, N_IN, F.WIN(), scr, r / NB_IN, 32 + r % NB_IN, F.lane); continue; } r -= I_IN;
            if (r < I_BF) { p0_transpose_item(F.w_bf(), FW, DM, F.WBF(), scr, r / 64, r % 64, F.lane); continue; } r -= I_BF;
            if (r < I_BS) { p0_transpose_item(F.w_bs(), SW, DM, F.WBS(), scr, r / 64, r % 64, F.lane); continue; } r -= I_BS;
            p0_transpose_item(F.w_out(), DM, DM, F.WOUT(), scr, r / 64, r % 64, F.lane);
        }
    }
    __syncthreads();
    {
        LAS float* tile = (LAS float*)F.lds;
        LAS float* ctab = (LAS float*)(F.lds + 33024);
        LAS float* stab = ctab + 128;
        LAS unsigned short* otile = (LAS unsigned short*)(F.lds + 34048);
        if (F.tid < 128) { float s, c; sincospif((float)F.tid * (1.0f / 64.0f), &s, &c); ctab[F.tid] = c * (1.0f / 1024.0f); stab[F.tid] = -s * (1.0f / 1024.0f); }
        for (int it = F.bid; it < 8 * 32; it += F.G) {
            const int g = it >> 5, k0 = (it & 31) * 64;
            __syncthreads();
            for (int i = F.tid; i < 64 * 128; i += 512) { const int kk = i >> 7, n2 = i & 127; tile[kk * 129 + n2] = F.w_in()[(size_t)(k0 + kk) * N_IN + g * 128 + n2]; }
            __syncthreads();
            const int kk = F.tid & 63;
            for (int ci = 0; ci < 16; ++ci) { const int c = (F.tid >> 6) + 8 * ci; const int cc = (c <= 64) ? c : c - 64; const LAS float* tab = (c <= 64) ? ctab : stab;
                float acc = 0.f;
#pragma unroll 8
                for (int n2 = 0; n2 < 128; ++n2) acc += tile[kk * 129 + n2] * tab[(n2 * cc) & 127];
                otile[c * 72 + kk] = (unsigned short)(pk2(acc, 0.f) & 0xffffu); }
            __syncthreads();
            for (int i = F.tid; i < 128 * 8; i += 512) { const int c = i >> 3, pc = i & 7;
                *(v4u*)(F.WIN() + (size_t)(g * 128 + c) * DM + k0 + pc * 8) = *(const LAS v4u*)(otile + c * 72 + pc * 8); }
        }
        __syncthreads();
    }
}

__device__ __forceinline__ float softplus(float v) { return fmaxf(v, 0.f) + log1pf(__expf(-fabsf(v))); }
__device__ __forceinline__ void p1b_dt(Frame& F) {
    const int fr = F.lane & 15, fq = F.lane >> 4, mt = F.wave >> 1, nt0 = 2 * (F.wave & 1);
    const bf16* WDT = F.WIN() + (size_t)COL_DT * DM;
    for (int rb = F.bid; rb < M / 64; rb += F.G) {
        const int r0 = rb * 64;
        f32x4 acc[2] = {{0.f, 0.f, 0.f, 0.f}, {0.f, 0.f, 0.f, 0.f}};
        const bf16* ap = F.XB() + (size_t)(r0 + 16 * mt + fr) * DM + 8 * fq;
        const bf16* bp0 = WDT + (size_t)(16 * nt0 + fr) * DM + 8 * fq;
        const bf16* bp1 = bp0 + (size_t)16 * DM;
#pragma unroll 8
        for (int ks = 0; ks < DM / 32; ++ks) { const bf16x8 a = *(const bf16x8*)(ap + 32 * ks), b0 = *(const bf16x8*)(bp0 + 32 * ks), b1 = *(const bf16x8*)(bp1 + 32 * ks);
            acc[0] = MFMA16(a, b0, acc[0]); acc[1] = MFMA16(a, b1, acc[1]); }
#pragma unroll
        for (int u = 0; u < 2; ++u) { const int n = 16 * (nt0 + u) + fr; const float bias = (n < 32) ? F.dtb_f()[n] : F.dtb_b()[n - 32];
#pragma unroll
            for (int j = 0; j < 4; ++j) F.DT()[(size_t)(r0 + 16 * mt + 4 * fq + j) * 64 + n] = softplus(acc[u][j] + bias); }
    }
}

__device__ __forceinline__ void p2a_fft1(Frame& F) {
    const int fr = F.lane & 15, fq = F.lane >> 4, w = F.wave;
    LAS unsigned char* YS = F.lds;
    LAS unsigned char* OUT = F.lds + 34816;
    bf16x8 fc[4][2], fs[4][2];
#pragma unroll
    for (int ni = 0; ni < 4; ++ni)
#pragma unroll
        for (int ks = 0; ks < 2; ++ks) { fc[ni][ks] = *(const bf16x8*)(F.F1C() + (16 * ni + fr) * 64 + 32 * ks + 8 * fq); fs[ni][ks] = *(const bf16x8*)(F.F1S() + (16 * ni + fr) * 64 + 32 * ks + 8 * fq); }
    for (int item = F.bid; item < 256; item += F.G) {
        const int b = item >> 7, nb = item & 127;
        float twc[4], tws[4];
#pragma unroll
        for (int ni = 0; ni < 4; ++ni) { const float2 t = F.TW()[(nb * (16 * ni + fr)) & 8191]; twc[ni] = t.x; tws[ni] = t.y; }
        for (int ch = 0; ch < 4; ++ch) {
#pragma unroll
            for (int i = 0; i < 4; ++i) { const int id = F.tid + 512 * i, row = id >> 5, pc = id & 31;
                *(LAS v4u*)(YS + row * 544 + pc * 16) = *(const v4u*)(F.YPK() + (size_t)(b * SEQ + 128 * row + nb) * FW + ch * 256 + pc * 8); }
            __syncthreads();
            f32x4 ar[2][4], ai[2][4];
#pragma unroll
            for (int mi = 0; mi < 2; ++mi)
#pragma unroll
                for (int ni = 0; ni < 4; ++ni) { ar[mi][ni] = (f32x4){0.f, 0.f, 0.f, 0.f}; ai[mi][ni] = (f32x4){0.f, 0.f, 0.f, 0.f}; }
#pragma unroll
            for (int ks = 0; ks < 2; ++ks)
#pragma unroll
                for (int mi = 0; mi < 2; ++mi) { const bf16x8 a = frag_tr(YS, 544, 32 * ks + 8 * fq, 32 * ks + 8 * fq + 4, 32 * w + 16 * mi, fr);
#pragma unroll
                    for (int ni = 0; ni < 4; ++ni) { ar[mi][ni] = MFMA16(a, fc[ni][ks], ar[mi][ni]); ai[mi][ni] = MFMA16(a, fs[ni][ks], ai[mi][ni]); } }
#pragma unroll
            for (int mi = 0; mi < 2; ++mi) { const int cl = 32 * w + 16 * mi + 4 * fq, gl = cl >> 7, cc = cl & 127;
#pragma unroll
                for (int ni = 0; ni < 4; ++ni) { const int ka = 16 * ni + fr; float r2[4], i2[4];
#pragma unroll
                    for (int j = 0; j < 4; ++j) { const float tr = ar[mi][ni][j], ti = ai[mi][ni][j]; float a = tr * twc[ni] + ti * tws[ni], bb = ti * twc[ni] - tr * tws[ni];
                        if (cc + j >= 65) { const float t = a; a = -bb; bb = t; }
                        r2[j] = a; i2[j] = bb; }
                    LAS unsigned char* o = OUT + ((ka * 2 + gl) * 2) * 256 + cc * 2;
                    *(LAS v2u*)o = (v2u){pk2(r2[0], r2[1]), pk2(r2[2], r2[3])};
                    *(LAS v2u*)(o + 256) = (v2u){pk2(i2[0], i2[1]), pk2(i2[2], i2[3])}; } }
            __syncthreads();
#pragma unroll
            for (int i = 0; i < 8; ++i) { const int id = F.tid + 512 * i, piece = id >> 4, off = (id & 15) * 16, ka = piece >> 2, gl = (piece >> 1) & 1, ri = piece & 1, g = ch * 2 + gl;
                *(v4u*)((unsigned char*)F.TP() + (((((size_t)(b * 64 + ka) * 8 + g) * 128 + nb) * 2 + ri) * 128) * 2 + off) = *(const LAS v4u*)(OUT + piece * 256 + off); }
            __syncthreads();
        }
    }
}

struct ConvW { float w[5][8]; float b[8]; };
__device__ __forceinline__ void conv_load_w(ConvW& cw, const float* conv_w, const float* conv_b, int col0) {
#pragma unroll
    for (int t = 0; t < 5; ++t) { const f32x4 a = *(const f32x4*)(conv_w + t * CONVCH + col0), b = *(const f32x4*)(conv_w + t * CONVCH + col0 + 4);
#pragma unroll
        for (int j = 0; j < 4; ++j) { cw.w[t][j] = a[j]; cw.w[t][4 + j] = b[j]; } }
    const f32x4 a = *(const f32x4*)(conv_b + col0), b = *(const f32x4*)(conv_b + col0 + 4);
#pragma unroll
    for (int j = 0; j < 4; ++j) { cw.b[j] = a[j]; cw.b[4 + j] = b[j]; }
}
__device__ __forceinline__ v4u conv8(const bf16* xb_, int t, int col0, const ConvW& cw) {
    float o[8];
#pragma unroll
    for (int j = 0; j < 8; ++j) o[j] = cw.b[j];
#pragma unroll
    for (int tap = 0; tap < 5; ++tap) { const int tt = t + tap - 2; const bool ok = (tt >= 0) && (tt < SEQ); const int tc = ok ? tt : t;
        const v4u r = *(const v4u*)(xb_ + (size_t)tc * CONVCH + col0); const float m = ok ? 1.f : 0.f;
        o[0] += cw.w[tap][0] * (m * bflo(r.x)); o[1] += cw.w[tap][1] * (m * bfhi(r.x)); o[2] += cw.w[tap][2] * (m * bflo(r.y)); o[3] += cw.w[tap][3] * (m * bfhi(r.y));
        o[4] += cw.w[tap][4] * (m * bflo(r.z)); o[5] += cw.w[tap][5] * (m * bfhi(r.z)); o[6] += cw.w[tap][6] * (m * bflo(r.w)); o[7] += cw.w[tap][7] * (m * bfhi(r.w)); }
#pragma unroll
    for (int j = 0; j < 8; ++j) o[j] = pg8::silu(o[j]);
    return (v4u){pk2(o[0], o[1]), pk2(o[2], o[3]), pk2(o[4], o[5]), pk2(o[6], o[7])};
}

constexpr int ST_HEAD_BYTES = 16384;
__device__ __forceinline__ size_t st_off(int dir, int b, int c, int hg) { return ((((size_t)(dir * 2 + b) * NCHUNK + c) * NHEAD + hg) * ST_HEAD_BYTES); }
__device__ __forceinline__ void p2b_states(Frame& F) {
    const int lane = F.lane, fr = lane & 15, fq = lane >> 4, w = F.wave;
    LAS unsigned char* BMi = F.lds;
    LAS unsigned char* XS = F.lds + 34816 + w * 6144;
    LAS float* TAB = (LAS float*)(F.lds + 34816 + 8 * 6144 + w * 1024);
    for (int it = F.bid; it < 512; it += F.G) {
        const int g = it & 3, c = (it >> 2) & 63, b = it >> 8, t0 = c * CHUNK, hg = g * 8 + w;
        const bf16* xb_ = F.XBC() + (size_t)b * SEQ * CONVCH;
        {
            const int chunk = F.tid & 15, col0 = 2048 + g * 128 + chunk * 8; ConvW cw; conv_load_w(cw, F.conv_w(), F.conv_b(), col0);
#pragma unroll
            for (int i = 0; i < 4; ++i) { const int t = (F.tid >> 4) + 32 * i; *(LAS v4u*)(BMi + t * 272 + chunk * 16) = conv8(xb_, t0 + t, col0, cw); }
        }
        {
            const float* dtp = F.DT() + (size_t)(b * SEQ + t0) * 64;
            const float df0 = dtp[lane * 64 + hg], df1 = dtp[(lane + 64) * 64 + hg], db0 = dtp[lane * 64 + 32 + hg], db1 = dtp[(lane + 64) * 64 + 32 + hg];
            const float Af = -__expf(F.alog_f()[hg]) * LOG2E, Ab = -__expf(F.alog_b()[hg]) * LOG2E;
            const float af0 = df0 * Af, af1 = df1 * Af, ab0 = db0 * Ab, ab1 = db1 * Ab;
            const float sf0 = wave_incl_scan(af0, lane), tf0 = __shfl(sf0, 63), sf1 = wave_incl_scan(af1, lane) + tf0, totf = __shfl(sf1, 63);
            const float sb0 = wave_incl_scan(ab0, lane), tb0 = __shfl(sb0, 63), sb1 = wave_incl_scan(ab1, lane) + tb0, totb = __shfl(sb1, 63);
            const float cb0 = totb - (sb0 - ab0), cb1 = totb - (sb1 - ab1);
            TAB[lane] = ex2(totf - sf0) * df0; TAB[64 + lane] = ex2(totf - sf1) * df1;
            TAB[128 + lane] = ex2(totb - cb0) * db0; TAB[192 + lane] = ex2(totb - cb1) * db1;
            if (lane == 0) { F.DEC()[((0 * 2 + b) * NCHUNK + c) * NHEAD + hg] = ex2(totf); F.DEC()[((1 * 2 + b) * NCHUNK + c) * NHEAD + hg] = ex2(totb); }
        }
        __syncthreads();
        for (int q = 0; q < 4; ++q) {
            {   const int chunk = lane & 1, col0 = g * 512 + w * 64 + q * 16 + chunk * 8; ConvW cw; conv_load_w(cw, F.conv_w(), F.conv_b(), col0);
#pragma unroll
                for (int i = 0; i < 4; ++i) { const int t = (lane >> 1) + 32 * i; *(LAS v4u*)(XS + t * 48 + chunk * 16) = conv8(xb_, t0 + t, col0, cw); } }
#pragma unroll
            for (int dir = 0; dir < 2; ++dir) {
                f32x4 acc[8];
#pragma unroll
                for (int mi = 0; mi < 8; ++mi) acc[mi] = (f32x4){0.f, 0.f, 0.f, 0.f};
#pragma unroll
                for (int ks = 0; ks < 4; ++ks) {
                    const v4u xr = __builtin_bit_cast(v4u, frag_tr(XS, 48, 32 * ks + 8 * fq, 32 * ks + 8 * fq + 4, 0, fr));
                    const f32x4 w0 = *(const LAS f32x4*)(TAB + dir * 128 + 32 * ks + 8 * fq), w1 = *(const LAS f32x4*)(TAB + dir * 128 + 32 * ks + 8 * fq + 4);
                    const bf16x8 bs = mk8(pk2(bflo(xr.x) * w0[0], bfhi(xr.x) * w0[1]), pk2(bflo(xr.y) * w0[2], bfhi(xr.y) * w0[3]), pk2(bflo(xr.z) * w1[0], bfhi(xr.z) * w1[1]), pk2(bflo(xr.w) * w1[2], bfhi(xr.w) * w1[3]));
#pragma unroll
                    for (int mi = 0; mi < 8; ++mi) { const bf16x8 a = frag_tr(BMi, 272, 32 * ks + 8 * fq, 32 * ks + 8 * fq + 4, 16 * mi, fr); acc[mi] = MFMA16(a, bs, acc[mi]); }
                }
                unsigned char* dst = (unsigned char*)F.ST() + st_off(dir, b, c, hg) + (size_t)(q * 4 * 64 + lane) * 16;
#pragma unroll
                for (int k2 = 0; k2 < 4; ++k2)
                    *(v4u*)(dst + k2 * 1024) = (v4u){pk2(acc[2 * k2][0], acc[2 * k2][1]), pk2(acc[2 * k2][2], acc[2 * k2][3]), pk2(acc[2 * k2 + 1][0], acc[2 * k2 + 1][1]), pk2(acc[2 * k2 + 1][2], acc[2 * k2 + 1][3])};
            }
        }
        __syncthreads();
    }
}

__device__ __forceinline__ void p3a_fft2(Frame& F) {
    const int lane = F.lane, fr = lane & 15, fq = lane >> 4, w = F.wave;
    LAS unsigned char* TB = F.lds;
    LAS unsigned char* WM = F.lds + 73728;
    int g_loaded = -1;
    for (int id = F.bid; id < 1024; id += F.G) {
        const int g = id & 7, ka = (id >> 3) & 63, b = id >> 9;
        __syncthreads();
        if (g != g_loaded) {
#pragma unroll
            for (int i = 0; i < 4; ++i) { const int u = F.tid + 512 * i, row = u >> 4, pc = u & 15; *(LAS v4u*)(WM + row * 272 + pc * 16) = *(const v4u*)(F.WMIX() + (size_t)g * 16384 + row * 128 + pc * 8); }
            g_loaded = g;
        }
        const bf16* src = F.TP() + ((size_t)(b * 64 + ka) * 8 + g) * 32768;
#pragma unroll
        for (int i = 0; i < 8; ++i) { const int u = F.tid + 512 * i, row = u >> 4, pc = u & 15; *(LAS v4u*)(TB + row * 288 + pc * 16) = *(const v4u*)(src + row * 128 + pc * 8); }
        __syncthreads();
        f32x4 d1[8];
#pragma unroll
        for (int ci = 0; ci < 8; ++ci) d1[ci] = (f32x4){0.f, 0.f, 0.f, 0.f};
#pragma unroll
        for (int ks = 0; ks < 8; ++ks) { const bf16x8 b1 = *(const bf16x8*)(F.W3() + (16 * w + fr) * 256 + 32 * ks + 8 * fq);
#pragma unroll
            for (int ci = 0; ci < 8; ++ci) { const bf16x8 a1 = frag_tr(TB, 288, 32 * ks + 8 * fq, 32 * ks + 8 * fq + 4, 16 * ci, fr); d1[ci] = MFMA16(a1, b1, d1[ci]); } }
        f32x4 d2[8];
#pragma unroll
        for (int oi = 0; oi < 8; ++oi) d2[oi] = (f32x4){0.f, 0.f, 0.f, 0.f};
#pragma unroll
        for (int k2 = 0; k2 < 4; ++k2) { const bf16x8 bf = mk8(pk2(d1[2 * k2][0], d1[2 * k2][1]), pk2(d1[2 * k2][2], d1[2 * k2][3]), pk2(d1[2 * k2 + 1][0], d1[2 * k2 + 1][1]), pk2(d1[2 * k2 + 1][2], d1[2 * k2 + 1][3]));
#pragma unroll
            for (int oi = 0; oi < 8; ++oi) { const LAS unsigned char* wp = WM + (16 * oi + fr) * 272 + (32 * k2 + 4 * fq) * 2; const v2u lo = *(const LAS v2u*)wp, hi = *(const LAS v2u*)(wp + 32);
                d2[oi] = MFMA16(mk8(lo.x, lo.y, hi.x, hi.y), bf, d2[oi]); } }
        const size_t token = (size_t)b * SEQ + ka + 64 * (16 * w + fr);
#pragma unroll
        for (int oi = 0; oi < 8; ++oi) { const int col = g * 128 + 16 * oi + 4 * fq; const f32x4 bias = *(const f32x4*)(F.fmix_b() + col); const v2u sz = *(const v2u*)(F.SZF() + token * FW + col);
            *(v2u*)(F.YPK() + token * FW + col) = (v2u){pk2((d2[oi][0] + bias[0]) * bflo(sz.x), (d2[oi][1] + bias[1]) * bfhi(sz.x)), pk2((d2[oi][2] + bias[2]) * bflo(sz.y), (d2[oi][3] + bias[3]) * bfhi(sz.y))}; }
    }
    __syncthreads();
}

__device__ __forceinline__ void p3b_scan(Frame& F) {
    for (int gid = F.bid * 512 + F.tid; gid < 131072; gid += F.G * 512) {
        const int unit = gid & 1023, h = (gid >> 10) & 31, b = (gid >> 15) & 1, dir = gid >> 16;
        float cr[8];
#pragma unroll
        for (int j = 0; j < 8; ++j) cr[j] = 0.f;
        for (int cb = 0; cb < NCHUNK; cb += 8) {
            v4u v[8]; float dc[8];
#pragma unroll
            for (int u = 0; u < 8; ++u) { const int c = dir ? (NCHUNK - 1 - (cb + u)) : (cb + u);
                v[u] = *(const v4u*)((const unsigned char*)F.ST() + st_off(dir, b, c, h) + (size_t)unit * 16); dc[u] = F.DEC()[((dir * 2 + b) * NCHUNK + c) * NHEAD + h]; }
#pragma unroll
            for (int u = 0; u < 8; ++u) { const int c = dir ? (NCHUNK - 1 - (cb + u)) : (cb + u);
                *(v4u*)((unsigned char*)F.ST() + st_off(dir, b, c, h) + (size_t)unit * 16) = (v4u){pk2(cr[0], cr[1]), pk2(cr[2], cr[3]), pk2(cr[4], cr[5]), pk2(cr[6], cr[7])};
                cr[0] = cr[0] * dc[u] + bflo(v[u].x); cr[1] = cr[1] * dc[u] + bfhi(v[u].x); cr[2] = cr[2] * dc[u] + bflo(v[u].y); cr[3] = cr[3] * dc[u] + bfhi(v[u].y);
                cr[4] = cr[4] * dc[u] + bflo(v[u].z); cr[5] = cr[5] * dc[u] + bfhi(v[u].z); cr[6] = cr[6] * dc[u] + bflo(v[u].w); cr[7] = cr[7] * dc[u] + bfhi(v[u].w); }
        }
    }
}

__device__ __forceinline__ void p4_ssd_out(Frame& F) {
    const int w = F.wave;
    LAS unsigned char* BMi = F.lds;
    LAS unsigned char* CMi = F.lds + 34816;
    LAS unsigned char* XS = F.lds + 69632 + w * 6144;
    LAS float* TAB = (LAS float*)(F.lds + 69632 + 49152 + w * 2048);
    LAS float* SSQ = (LAS float*)(F.lds + 69632 + 49152 + 16384);
    bf16* Y = F.TP();
#pragma unroll 1
    for (int it = F.bid; it < 512; it += F.G) {
        int lane_ = F.lane; asm volatile("" : "+v"(lane_));
        const int lane = lane_, fr = lane & 15, fq = lane >> 4;
        const int g = it & 3, c = (it >> 2) & 63, b = it >> 8, t0 = c * CHUNK, hg = g * 8 + w;
        const bf16* xb_ = F.XBC() + (size_t)b * SEQ * CONVCH;
        {
            const int chunk = F.tid & 31, isC = chunk >> 4, col0 = 2048 + isC * 512 + g * 128 + (chunk & 15) * 8; ConvW cw; conv_load_w(cw, F.conv_w(), F.conv_b(), col0);
            LAS unsigned char* dst = (isC ? CMi : BMi) + (chunk & 15) * 16;
#pragma unroll 2
            for (int i = 0; i < 8; ++i) { const int t = (F.tid >> 5) + 16 * i; *(LAS v4u*)(dst + t * 272) = conv8(xb_, t0 + t, col0, cw); }
        }
        {
            const float* dtp = F.DT() + (size_t)(b * SEQ + t0) * 64;
            const float df0 = dtp[lane * 64 + hg], df1 = dtp[(lane + 64) * 64 + hg], db0 = dtp[lane * 64 + 32 + hg], db1 = dtp[(lane + 64) * 64 + 32 + hg];
            const float Af = -__expf(F.alog_f()[hg]) * LOG2E, Ab = -__expf(F.alog_b()[hg]) * LOG2E;
            const float af0 = df0 * Af, af1 = df1 * Af, ab0 = db0 * Ab, ab1 = db1 * Ab;
            const float sf0 = wave_incl_scan(af0, lane), tf0 = __shfl(sf0, 63), sf1 = wave_incl_scan(af1, lane) + tf0;
            const float sb0 = wave_incl_scan(ab0, lane), tb0 = __shfl(sb0, 63), sb1 = wave_incl_scan(ab1, lane) + tb0, totb = __shfl(sb1, 63);
            TAB[lane] = sf0; TAB[64 + lane] = sf1; TAB[128 + lane] = totb - (sb0 - ab0); TAB[192 + lane] = totb - (sb1 - ab1);
            TAB[256 + lane] = df0; TAB[320 + lane] = df1; TAB[384 + lane] = db0; TAB[448 + lane] = db1;
        }
        __syncthreads();
        {
            f32x4 d1[8];
#pragma unroll
            for (int si = 0; si < 8; ++si) d1[si] = (f32x4){0.f, 0.f, 0.f, 0.f};
#pragma unroll 1
            for (int ks = 0; ks < 4; ++ks) {
                const bf16x8 b1 = *(const LAS bf16x8*)(CMi + (16 * w + fr) * 272 + (32 * ks + 8 * fq) * 2);
#pragma unroll
                for (int si = 0; si < 8; ++si) { const bf16x8 a1 = *(const LAS bf16x8*)(BMi + (16 * si + fr) * 272 + (32 * ks + 8 * fq) * 2); d1[si] = MFMA16(a1, b1, d1[si]); }
            }
            __syncthreads();
#pragma unroll
            for (int si = 0; si < 8; ++si) *(LAS v2u*)(BMi + (16 * w + fr) * 272 + (16 * si + 4 * fq) * 2) = (v2u){pk2(d1[si][0], d1[si][1]), pk2(d1[si][2], d1[si][3])};
        }
        bf16x8 XSf[4][4];
#pragma unroll
        for (int q = 0; q < 4; ++q) {
            {   const int chunk = lane & 1, col0 = g * 512 + w * 64 + q * 16 + chunk * 8; ConvW cw; conv_load_w(cw, F.conv_w(), F.conv_b(), col0);
#pragma unroll 1
                for (int i = 0; i < 4; ++i) { const int t = (lane >> 1) + 32 * i; *(LAS v4u*)(XS + t * 48 + chunk * 16) = conv8(xb_, t0 + t, col0, cw); } }
#pragma unroll
            for (int ks = 0; ks < 4; ++ks) XSf[q][ks] = frag_tr(XS, 48, 32 * ks + 4 * fq, 32 * ks + 16 + 4 * fq, 0, fr);
            __builtin_amdgcn_sched_barrier(0);
        }
        __syncthreads();
        const float dsk = F.d_skip()[hg];
#pragma unroll 1
        for (int tg = 0; tg < 4; ++tg) {
            int lane2_ = lane_; asm volatile("" : "+v"(lane2_));
            const int lane = lane2_, fr = lane & 15, fq = lane >> 4;
            const unsigned char* PF = (const unsigned char*)F.ST() + st_off(0, b, c, hg) + (size_t)lane * 16;
            const unsigned char* PB = (const unsigned char*)F.ST() + st_off(1, b, c, hg) + (size_t)lane * 16;
            bf16x8 Gf[2][4];
            {
                const int tA = 16 * (2 * tg) + fr, tB = tA + 16;
                const float cftA = TAB[tA], cbtA = TAB[128 + tA], cftB = TAB[tB], cbtB = TAB[128 + tB];
#pragma unroll
                for (int ks = 0; ks < 4; ++ks) { unsigned pkA[4], pkB[4];
#pragma unroll
                    for (int u = 0; u < 2; ++u) { const int si = 2 * ks + u;
                        const f32x4 cfs = *(const LAS f32x4*)(TAB + 16 * si + 4 * fq), cbs = *(const LAS f32x4*)(TAB + 128 + 16 * si + 4 * fq), dfs = *(const LAS f32x4*)(TAB + 256 + 16 * si + 4 * fq), dbs = *(const LAS f32x4*)(TAB + 384 + 16 * si + 4 * fq);
#pragma unroll
                        for (int tl = 0; tl < 2; ++tl) { const int t = tl ? tB : tA; const float cft = tl ? cftB : cftA, cbt = tl ? cbtB : cbtA; float gv[4];
                            const v2u cbr = *(const LAS v2u*)(BMi + t * 272 + (16 * si + 4 * fq) * 2); const float cbv[4] = {bflo(cbr.x), bfhi(cbr.x), bflo(cbr.y), bfhi(cbr.y)};
                            const int d0 = 16 * (si - 2 * tg - tl) + 4 * fq - fr;
#pragma unroll
                            for (int j = 0; j < 4; ++j) { const int d = d0 + j;
                                const float arg = (d < 0) ? (cft - cfs[j]) : (cbt - cbs[j]), sc = (d < 0) ? dfs[j] : dbs[j];
                                float e = ex2(fminf(arg, 0.f)) * sc; e = (d == 0) ? (dfs[j] + dbs[j]) : e;
                                gv[j] = cbv[j] * e + ((d == 0) ? dsk : 0.f); }
                            if (tl) { pkB[2 * u] = pk2(gv[0], gv[1]); pkB[2 * u + 1] = pk2(gv[2], gv[3]); } else { pkA[2 * u] = pk2(gv[0], gv[1]); pkA[2 * u + 1] = pk2(gv[2], gv[3]); } }
                    }
                    Gf[0][ks] = mk8(pkA[0], pkA[1], pkA[2], pkA[3]); Gf[1][ks] = mk8(pkB[0], pkB[1], pkB[2], pkB[3]);
                    __builtin_amdgcn_sched_barrier(0);
                }
            }
            __builtin_amdgcn_sched_barrier(0);
            f32x4 acc[4][2];
#pragma unroll
            for (int pi = 0; pi < 4; ++pi) { acc[pi][0] = (f32x4){0.f, 0.f, 0.f, 0.f}; acc[pi][1] = (f32x4){0.f, 0.f, 0.f, 0.f}; }
#pragma unroll
            for (int pi = 0; pi < 4; ++pi)
#pragma unroll
                for (int ks = 0; ks < 4; ++ks) { acc[pi][0] = MFMA16(XSf[pi][ks], Gf[0][ks], acc[pi][0]); acc[pi][1] = MFMA16(XSf[pi][ks], Gf[1][ks], acc[pi][1]); }
#pragma unroll
            for (int dir = 0; dir < 2; ++dir) {
                bf16x8 Cs[2][4];
#pragma unroll
                for (int tl = 0; tl < 2; ++tl) {
                    const int t = 16 * (2 * tg + tl) + fr; const float e = ex2(TAB[dir * 128 + t]);
#pragma unroll
                    for (int ks = 0; ks < 4; ++ks) {
                        const LAS unsigned char* cp = CMi + t * 272 + (32 * ks + 4 * fq) * 2; const v2u lo = *(const LAS v2u*)cp, hi = *(const LAS v2u*)(cp + 32);
                        Cs[tl][ks] = mk8(pk2(bflo(lo.x) * e, bfhi(lo.x) * e), pk2(bflo(lo.y) * e, bfhi(lo.y) * e), pk2(bflo(hi.x) * e, bfhi(hi.x) * e), pk2(bflo(hi.y) * e, bfhi(hi.y) * e));
                    }
                }
                const unsigned char* PS = dir ? PB : PF;
#pragma unroll
                for (int pi = 0; pi < 4; ++pi) {
#pragma unroll
                    for (int ks = 0; ks < 4; ++ks) { const bf16x8 sf = *(const bf16x8*)(PS + (pi * 4 + ks) * 1024); acc[pi][0] = MFMA16(sf, Cs[0][ks], acc[pi][0]); acc[pi][1] = MFMA16(sf, Cs[1][ks], acc[pi][1]); }
                    __builtin_amdgcn_sched_barrier(0);
                }
            }
            float ssq0 = 0.f, ssq1 = 0.f;
#pragma unroll
            for (int pi = 0; pi < 4; ++pi) {
                const int ch = hg * 64 + 16 * pi + 4 * fq;
                {   const size_t token = (size_t)b * SEQ + t0 + 16 * (2 * tg) + fr; const v2u sz = *(const v2u*)(F.SZS() + token * SW + ch);
                    const float h0 = acc[pi][0][0] * bflo(sz.x), h1 = acc[pi][0][1] * bfhi(sz.x), h2 = acc[pi][0][2] * bflo(sz.y), h3 = acc[pi][0][3] * bfhi(sz.y);
                    ssq0 += h0 * h0 + h1 * h1 + h2 * h2 + h3 * h3; *(v2u*)(Y + token * SW + ch) = (v2u){pk2(h0, h1), pk2(h2, h3)}; }
                {   const size_t token = (size_t)b * SEQ + t0 + 16 * (2 * tg + 1) + fr; const v2u sz = *(const v2u*)(F.SZS() + token * SW + ch);
                    const float h0 = acc[pi][1][0] * bflo(sz.x), h1 = acc[pi][1][1] * bfhi(sz.x), h2 = acc[pi][1][2] * bflo(sz.y), h3 = acc[pi][1][3] * bfhi(sz.y);
                    ssq1 += h0 * h0 + h1 * h1 + h2 * h2 + h3 * h3; *(v2u*)(Y + token * SW + ch) = (v2u){pk2(h0, h1), pk2(h2, h3)}; }
            }
            ssq0 += __shfl_xor(ssq0, 16); ssq0 += __shfl_xor(ssq0, 32); ssq1 += __shfl_xor(ssq1, 16); ssq1 += __shfl_xor(ssq1, 32);
            if (fq == 0) { SSQ[w * 128 + 16 * (2 * tg) + fr] = ssq0; SSQ[w * 128 + 16 * (2 * tg + 1) + fr] = ssq1; }
        }
        __syncthreads();
#pragma unroll
        for (int ti = 0; ti < 8; ++ti) {
            const int t = 16 * ti + fr; float tot = 0.f;
#pragma unroll
            for (int ww = 0; ww < 8; ++ww) tot += SSQ[ww * 128 + t];
            const float rs = 1.0f / sqrtf(tot * (1.0f / 512.0f) + LN_EPS);
            const size_t token = (size_t)b * SEQ + t0 + t;
#pragma unroll
            for (int pi = 0; pi < 4; ++pi) { const int ch = hg * 64 + 16 * pi + 4 * fq; const f32x4 nw = *(const f32x4*)(F.norm_w() + ch); bf16* yp = Y + token * SW + ch; const v2u hv = *(const v2u*)yp;
                *(v2u*)yp = (v2u){pk2(bflo(hv.x) * rs * nw[0], bfhi(hv.x) * rs * nw[1]), pk2(bflo(hv.y) * rs * nw[2], bfhi(hv.y) * rs * nw[3])}; }
        }
        __syncthreads();
    }
}

__device__ __forceinline__ void p7_layernorm(Frame& F) {
    const int gw = F.bid * NWAVES + F.wave, NGW = F.G * NWAVES;
    for (int m = gw; m < M; m += NGW) {
        f32x4* xr = (f32x4*)(F.out + (size_t)m * DM) + F.lane;
        f32x4 v[8]; float s = 0.f;
#pragma unroll
        for (int j = 0; j < 8; ++j) { v[j] = xr[64 * j]; s += (v[j][0] + v[j][1]) + (v[j][2] + v[j][3]); }
        const float mean = wave_sum(s) * (1.0f / DM); float s2 = 0.f;
#pragma unroll
        for (int j = 0; j < 8; ++j) { v[j] = v[j] - mean; s2 += (v[j][0] * v[j][0] + v[j][1] * v[j][1]) + (v[j][2] * v[j][2] + v[j][3] * v[j][3]); }
        const float rstd = 1.0f / sqrtf(wave_sum(s2) * (1.0f / DM) + LN_EPS);
#pragma unroll
        for (int j = 0; j < 8; ++j) { const f32x4 gg = *((const f32x4*)F.ln_g() + F.lane + 64 * j), bb = *((const f32x4*)F.ln_b() + F.lane + 64 * j); xr[64 * j] = v[j] * rstd * gg + bb; }
    }
}

struct Args { const float* in[18]; float* out; unsigned char* ws; int ph_lo, ph_hi; };
__global__ void __launch_bounds__(NWAVES * 64, 2) hybrid_fwd(Args args) {
    extern __shared__ __attribute__((aligned(16))) unsigned char lds[];
    Frame F;
    F.lds = (LAS unsigned char*)lds;
    F.MISC = (volatile LAS unsigned*)(F.lds + MISC_OFF);
    F.tid = threadIdx.x; F.lane = F.tid & 63; F.wave = __builtin_amdgcn_readfirstlane(F.tid >> 6);
    F.G = gridDim.x; F.bid = blockIdx.x;
    unsigned char* ws = args.ws;
    F.ctl = (gu32*)(ws + WS_CTL);
    F.in = args.in; F.out = args.out; F.ws = ws;
    for (int u = F.tid; u < 64; u += NWAVES * 64) ((LAS unsigned*)(F.lds + MISC_OFF))[u] = 0u;
    __syncthreads();
    XcdBarrier bar = xcd_barrier_post((unsigned*)(F.ctl + CW_BAR), F.MISC + 8);
    const int lo = args.ph_lo, hi = args.ph_hi;
#ifndef PHASE_MASK
#define PHASE_MASK 0xFF
#endif
#define IN(k) (((PHASE_MASK >> (k)) & 1) && lo <= (k) && (k) < hi)
#define SEAM(k) do { if (IN(k) && IN((k) + 1)) xcd_barrier(bar); } while (0)
    if (IN(0)) { p0_prologue(F); } SEAM(0);
    if (IN(1)) {
        pg8::Gemm gm{F.XB(), F.WIN(), M, N_P1, DM}; pg8::StaticOrder S; S.init(M, N_P1, F.G, F.bid);
        pg8::EpiInProj E{F.YPK(), F.SZF(), F.SZS(), F.XBC()};
        pg8::gemm_phase<pg8::EpiInProj, pg8::StaticOrder, true, true>(F.lds, gm, S, E);
        p1b_dt(F);
    } SEAM(1);
    if (IN(2)) { p2a_fft1(F); p2b_states(F); } SEAM(2);
    if (IN(3)) { p3a_fft2(F); p3b_scan(F); } SEAM(3);
    if (IN(4)) { p4_ssd_out(F); } SEAM(4);
    if (IN(5)) {
        bf16* S1 = F.XBC(); bf16* S2 = F.SZS(); bf16* Mb = F.XBC();
        pg8::StaticOrder S; S.init(M, DM, F.G, F.bid);
        { pg8::Gemm gm{F.XB(), F.WIN() + (size_t)COL_GATE * DM, M, DM, DM}; pg8::EpiGate E{S1, DM, F.b_gate()};
          pg8::gemm_phase<pg8::EpiGate, pg8::StaticOrder, true, true>(F.lds, gm, S, E); }
        { pg8::Gemm gm{F.YPK(), F.WBF(), M, DM, FW}; pg8::EpiMul<0> E{S1, nullptr, nullptr, DM};
          pg8::gemm_phase<pg8::EpiMul<0>, pg8::StaticOrder, true, true>(F.lds, gm, S, E); }
        { pg8::Gemm gm{F.XB(), F.WIN() + (size_t)(COL_GATE + DM) * DM, M, DM, DM}; pg8::EpiGate E{S2, DM, F.b_gate() + DM};
          pg8::gemm_phase<pg8::EpiGate, pg8::StaticOrder, true, true>(F.lds, gm, S, E); }
        { pg8::Gemm gm{F.TP(), F.WBS(), M, DM, SW}; pg8::EpiMul<1> E{S1, S2, Mb, DM};
          pg8::gemm_phase<pg8::EpiMul<1>, pg8::StaticOrder, true, true>(F.lds, gm, S, E); }
    } SEAM(5);
    if (IN(6)) {
        pg8::Gemm gm{F.XBC(), F.WOUT(), M, DM, DM}; pg8::StaticOrder S; S.init(M, DM, F.G, F.bid);
        pg8::EpiOut E{F.out, F.x(), DM, DN_ALPHA};
        pg8::gemm_phase<pg8::EpiOut, pg8::StaticOrder, true, true>(F.lds, gm, S, E);
    } SEAM(6);
    if (IN(7)) { p7_layernorm(F); }
#undef IN
#undef SEAM
}

#ifndef MK_CUTS
#define MK_CUTS 1
#endif
extern "C" void kernel_launch(void* const* d_in, const int* in_sizes, int n_in, void* d_out, int out_size, void* d_ws, size_t ws_size, hipStream_t stream) {
    static int grid = 0;
    if (grid == 0) {
        if (n_in != 18 || in_sizes[0] != M * DM || out_size != M * DM || ws_size < WS_END) { fprintf(stderr, "kernel_launch: unexpected shapes (n_in %d, in0 %d, out %d, ws %zu)\n", n_in, n_in > 0 ? in_sizes[0] : -1, out_size, ws_size); grid = -1; return; }
        int dev = 0, cus = 0, per_cu = 0;
        if (hipGetDevice(&dev) != hipSuccess || hipDeviceGetAttribute(&cus, hipDeviceAttributeMultiprocessorCount, dev) != hipSuccess) { grid = -1; return; }
        if (hipFuncSetAttribute((const void*)hybrid_fwd, hipFuncAttributeMaxDynamicSharedMemorySize, LDS_BYTES) != hipSuccess) { fprintf(stderr, "kernel_launch: hipFuncSetAttribute failed\n"); grid = -1; return; }
        if (hipOccupancyMaxActiveBlocksPerMultiprocessor(&per_cu, (const void*)hybrid_fwd, NWAVES * 64, LDS_BYTES) != hipSuccess || per_cu < 1) fprintf(stderr, "kernel_launch: occupancy query reports %d\n", per_cu);
        (void)hipGetLastError();
        grid = cus;
    }
    if (grid < 0) return;
    if (hipMemsetAsync((char*)d_ws + WS_CTL, 0, CTL_ZERO_BYTES, stream) != hipSuccess) { fprintf(stderr, "kernel_launch: memset failed\n"); return; }
    Args a{};
    for (int i = 0; i < 18; ++i) a.in[i] = (const float*)d_in[i];
    a.out = (float*)d_out; a.ws = (unsigned char*)d_ws;
#if MK_CUTS
    for (int p = 0; p < 8; ++p) { a.ph_lo = p; a.ph_hi = p + 1; hipLaunchKernelGGL(hybrid_fwd, dim3(grid), dim3(NWAVES * 64), LDS_BYTES, stream, a); }
#else
    a.ph_lo = 0; a.ph_hi = 8;
    hipLaunchKernelGGL(hybrid_fwd, dim3(grid), dim3(NWAVES * 64), LDS_BYTES, stream, a);
#endif
    const hipError_t le = hipPeekAtLastError();
    if (le != hipSuccess) fprintf(stderr, "kernel_launch: launch failed: %s\n", hipGetErrorName(le));
}
```

```cpp
#include <hip/hip_runtime.h>
#include <cstdio>
#include <cstdint>
namespace pg8 {
#define PG8_LAS __attribute__((address_space(3)))
typedef unsigned short bf16_t;
typedef short bf16x8 __attribute__((ext_vector_type(8)));
typedef float f32x4 __attribute__((ext_vector_type(4)));
typedef unsigned u32x4 __attribute__((ext_vector_type(4)));
constexpr int BM = 256, BK = 64, HALF = 128, HTB = HALF * BK * 2  , STAGE_BYTES = 8 * HTB, NXCD = 8, WGM = 8;

__host__ __device__ __forceinline__ int lds_byte(int r, int c) { const int st = (r >> 4) * 2 + (c >> 5), rr = r & 15, cc = c & 31, ob = rr * 64 + cc * 2; return st * 1024 + (ob ^ (((ob >> 9) & 1) << 5)); }
__host__ __device__ __forceinline__ void stage_rc(int b, int& R, int& C) { const int st = b / 1024, sb = b % 1024, swz = sb ^ (((sb >> 9) & 1) << 5); R = (st >> 1) * 16 + swz / 64; C = (st & 1) * 32 + (swz % 64) / 2; }
__host__ __device__ __forceinline__ int perm32(int rho) { const int n = rho >> 4, i = rho & 15; return 8 * (i >> 2) + 4 * n + (i & 3); }

struct Unit { int pm, pn; };
struct Gemm { const bf16_t* A; const bf16_t* Bt; int M, N, K; };

struct StaticOrder {
    int nM, nN, nwg, G, c;
    __host__ __device__ void init(int M, int N, int G_, int c_) { nM = M / BM; nN = N / BM; nwg = nM * nN; G = G_; c = c_; }
    __host__ __device__ bool next(int i, Unit& u) const {
        const long L = (long)i * G + c; if (L >= nwg) return false;
        int wgid = (int)L; { const int q = nwg / NXCD, r = nwg % NXCD, xcd = wgid % NXCD, off = wgid / NXCD; wgid = (xcd < r ? xcd * (q + 1) : r * (q + 1) + (xcd - r) * q) + off; }
        const int nig = WGM * nN, gid = wgid / nig, fm = gid * WGM, gsz = (nM - fm) < WGM ? (nM - fm) : WGM;
        u.pm = fm + ((wgid % nig) % gsz); u.pn = (wgid % nig) / gsz; return true;
    }
    __device__ __forceinline__ void a_ready(const Unit&) const {}
    __device__ __forceinline__ void done(const Unit&) const {}
};

typedef float cvt_f32x2 __attribute__((ext_vector_type(2))); typedef __bf16 cvt_bf16x2 __attribute__((ext_vector_type(2)));
__device__ __forceinline__ unsigned cvt_pk_bf16(float lo, float hi) { const cvt_f32x2 v = {lo, hi}; const cvt_bf16x2 b = __builtin_convertvector(v, cvt_bf16x2); return __builtin_bit_cast(unsigned, b); }
__device__ __forceinline__ float bflo(unsigned w) { return __builtin_bit_cast(float, w << 16); }
__device__ __forceinline__ float bfhi(unsigned w) { return __builtin_bit_cast(float, w & 0xffff0000u); }
__device__ __forceinline__ float sigm(float v) { return __builtin_amdgcn_rcpf(1.0f + __builtin_amdgcn_exp2f(-1.4426950408889634f * v)); }
__device__ __forceinline__ float silu(float v) { return v * sigm(v); }
__device__ __forceinline__ u32x4 pack8(const f32x4& v0, const f32x4& v1) { u32x4 w; w.x = cvt_pk_bf16(v0[0], v0[1]); w.y = cvt_pk_bf16(v0[2], v0[3]); w.z = cvt_pk_bf16(v1[0], v1[1]); w.w = cvt_pk_bf16(v1[2], v1[3]); return w; }
__device__ __forceinline__ void unpack8(const u32x4& w, f32x4& v0, f32x4& v1) { v0 = (f32x4){bflo(w.x), bfhi(w.x), bflo(w.y), bfhi(w.y)}; v1 = (f32x4){bflo(w.z), bfhi(w.z), bflo(w.w), bfhi(w.w)}; }

struct EpiInProj {
    static constexpr bool PERM = true, AFTER_DRAIN = false;
    bf16_t *ypk, *szf, *szs, *xbc;
    __device__ __forceinline__ void operator()(const f32x4 (&acc)[2][2][4][2], const Unit& u, int wr, int wc, int fr, int fq) const {
        const int pn = u.pn; bf16_t* base; int ldc, colt; bool act;
        if (pn < 4) { base = ypk; ldc = 1024; colt = pn * BM; act = false; }
        else if (pn < 8) { base = szf; ldc = 1024; colt = (pn - 4) * BM; act = true; }
        else if (pn < 16) { base = szs; ldc = 2048; colt = (pn - 8) * BM; act = true; }
        else { base = xbc; ldc = 3072; colt = (pn - 16) * BM; act = false; }
        const int row0 = u.pm * BM + wr * 64 + fr, col0 = colt + wc * 32 + 8 * fq;
#pragma unroll
        for (int ai = 0; ai < 2; ++ai)
#pragma unroll
            for (int m = 0; m < 4; ++m) { bf16_t* rowp = base + (size_t)(row0 + ai * HALF + m * 16) * ldc + col0;
#pragma unroll
                for (int bj = 0; bj < 2; ++bj) { f32x4 v0 = acc[ai][bj][m][0], v1 = acc[ai][bj][m][1];
                    if (act) {
#pragma unroll
                        for (int j = 0; j < 4; ++j) { v0[j] = silu(v0[j]); v1[j] = silu(v1[j]); } }
                    *(u32x4*)(rowp + bj * HALF) = pack8(v0, v1); } }
    }
};
struct EpiGate {
    static constexpr bool PERM = true, AFTER_DRAIN = false;
    bf16_t* S; int ldc; const float* bias;
    __device__ __forceinline__ void operator()(const f32x4 (&acc)[2][2][4][2], const Unit& u, int wr, int wc, int fr, int fq) const {
        const int row0 = u.pm * BM + wr * 64 + fr, col0 = u.pn * BM + wc * 32 + 8 * fq;
        f32x4 bv[2][2];
#pragma unroll
        for (int bj = 0; bj < 2; ++bj)
#pragma unroll
            for (int n = 0; n < 2; ++n) bv[bj][n] = *(const f32x4*)(bias + col0 + bj * HALF + 4 * n);
#pragma unroll
        for (int ai = 0; ai < 2; ++ai)
#pragma unroll
            for (int m = 0; m < 4; ++m) { bf16_t* rowp = S + (size_t)(row0 + ai * HALF + m * 16) * ldc + col0;
#pragma unroll
                for (int bj = 0; bj < 2; ++bj) { f32x4 v0 = acc[ai][bj][m][0] + bv[bj][0], v1 = acc[ai][bj][m][1] + bv[bj][1];
#pragma unroll
                    for (int j = 0; j < 4; ++j) { v0[j] = sigm(v0[j]); v1[j] = sigm(v1[j]); }
                    *(u32x4*)(rowp + bj * HALF) = pack8(v0, v1); } }
    }
};
template <int MODE> struct EpiMul {
    static constexpr bool PERM = true, AFTER_DRAIN = false;
    bf16_t* S1; const bf16_t* S2; bf16_t* O; int ldc;
    __device__ __forceinline__ void operator()(const f32x4 (&acc)[2][2][4][2], const Unit& u, int wr, int wc, int fr, int fq) const {
        const int row0 = u.pm * BM + wr * 64 + fr, col0 = u.pn * BM + wc * 32 + 8 * fq;
#pragma unroll
        for (int ai = 0; ai < 2; ++ai)
#pragma unroll
            for (int m = 0; m < 4; ++m) { const size_t off = (size_t)(row0 + ai * HALF + m * 16) * ldc + col0;
#pragma unroll
                for (int bj = 0; bj < 2; ++bj) {
                    f32x4 a0, a1; unpack8(*(const u32x4*)(S1 + off + bj * HALF), a0, a1);
                    if (MODE == 0) { *(u32x4*)(S1 + off + bj * HALF) = pack8(a0 * acc[ai][bj][m][0], a1 * acc[ai][bj][m][1]); }
                    else { f32x4 g0, g1; unpack8(*(const u32x4*)(S2 + off + bj * HALF), g0, g1);
                           *(u32x4*)(O + off + bj * HALF) = pack8(a0 + g0 * acc[ai][bj][m][0], a1 + g1 * acc[ai][bj][m][1]); } } }
    }
};
struct EpiOut {
    static constexpr bool PERM = false, AFTER_DRAIN = false;
    float* C; const float* X; int ldc; float alpha;
    __device__ __forceinline__ void operator()(const f32x4 (&acc)[2][2][4][2], const Unit& u, int wr, int wc, int fr, int fq) const {
        const int row0 = u.pm * BM + wr * 64 + fr, col0 = u.pn * BM + wc * 32 + 4 * fq;
#pragma unroll
        for (int ai = 0; ai < 2; ++ai)
#pragma unroll
            for (int m = 0; m < 4; ++m) { const size_t off = (size_t)(row0 + ai * HALF + m * 16) * ldc + col0;
#pragma unroll
                for (int bj = 0; bj < 2; ++bj)
#pragma unroll
                    for (int n = 0; n < 2; ++n) { const f32x4 xv = *(const f32x4*)(X + off + bj * HALF + n * 16);
                        *(f32x4*)(C + off + bj * HALF + n * 16) = xv * alpha + acc[ai][bj][m][n]; } }
    }
};
template <class Epi, class Sched, bool ALIGN_EPI = false, bool SP2 = false>
__device__ __forceinline__ void gemm_phase(PG8_LAS unsigned char* lds, const Gemm g, const Sched& S, const Epi& E) {
    const int tid = threadIdx.x, wid = __builtin_amdgcn_readfirstlane(tid >> 6), lane = tid & 63, wr = wid >> 2, wc = wid & 3, fr = lane & 15, fq = lane >> 4;
    const int K = g.K, nt = K / BK;
    unsigned voffA[2], voffB[2];
#pragma unroll
    for (int i = 0; i < 2; ++i) { int R, C; stage_rc(tid * 16 + i * 8192, R, C); const int Rb = Epi::PERM ? ((R & ~31) + perm32(R & 31)) : R;
        voffA[i] = (unsigned)(R * K + C) * 2u; voffB[i] = (unsigned)(Rb * K + C) * 2u; }
    const size_t kstep = (size_t)(BK * 2);
    const size_t hstep = (size_t)HALF * K * 2;
    const size_t tstep = 2 * hstep;
    const unsigned ldsw = (unsigned)wid * 1024u;
    const int aoff = lds_byte(wr * 64 + fr, fq * 8), boff = lds_byte(wc * 32 + fr, fq * 8);
#define PG8_SA(b, h) (((b) * 2 + (h)) * HTB)
#define PG8_SB(b, h) ((4 + (b) * 2 + (h)) * HTB)
#define PG8_STAGE(bufoff, gbase, voff) do { _Pragma("unroll") for (int _i = 0; _i < 2; ++_i) \
        __builtin_amdgcn_global_load_lds((const unsigned*)((const char*)(gbase) + (voff)[_i]), (PG8_LAS unsigned*)(lds + (bufoff) + ldsw + _i * 8192), 16, 0, 0); } while (0)
#define PG8_LDA(dst, b, h) do { _Pragma("unroll") for (int m = 0; m < 4; ++m) _Pragma("unroll") for (int k = 0; k < 2; ++k) dst[m][k] = *(const PG8_LAS bf16x8*)(lds + PG8_SA(b, h) + aoff + m * 2048 + k * 1024); } while (0)
#define PG8_LDB(dst, b, h) do { _Pragma("unroll") for (int n = 0; n < 2; ++n) _Pragma("unroll") for (int k = 0; k < 2; ++k) dst[n][k] = *(const PG8_LAS bf16x8*)(lds + PG8_SB(b, h) + boff + n * 2048 + k * 1024); } while (0)
#define PG8_MMA(ai, bj, At, Bt) do { __builtin_amdgcn_s_setprio(1); _Pragma("unroll") for (int m = 0; m < 4; ++m) _Pragma("unroll") for (int n = 0; n < 2; ++n) _Pragma("unroll") for (int k = 0; k < 2; ++k) \
        acc[ai][bj][m][n] = __builtin_amdgcn_mfma_f32_16x16x32_bf16(Bt[n][k], At[m][k], acc[ai][bj][m][n], 0, 0, 0); __builtin_amdgcn_s_setprio(0); } while (0)
#define PG8_WAIT_V(n) asm volatile("s_waitcnt vmcnt(" #n ")" ::: "memory")
#define PG8_WAIT_L(n) asm volatile("s_waitcnt lgkmcnt(" #n ")" ::: "memory")
#define PG8_BAR __builtin_amdgcn_s_barrier()
#define PG8_SCHED __builtin_amdgcn_sched_barrier(0)
    Unit cur, nxt; int ui = 0;
    if (!S.next(0, cur)) return;
    f32x4 acc[2][2][4][2];
#pragma unroll
    for (int a = 0; a < 2; ++a)
#pragma unroll
        for (int b = 0; b < 2; ++b)
#pragma unroll
            for (int m = 0; m < 4; ++m)
#pragma unroll
                for (int n = 0; n < 2; ++n) acc[a][b][m][n] = (f32x4){0.f, 0.f, 0.f, 0.f};
    bf16x8 At[4][2], B0[2][2], B1[2][2];
    const char* cA = (const char*)g.A + (size_t)cur.pm * tstep; const char* cB = (const char*)g.Bt + (size_t)cur.pn * tstep;
    S.a_ready(cur);
    if constexpr (SP2) {
        PG8_STAGE(PG8_SB(0, 0), cB, voffB); PG8_STAGE(PG8_SB(0, 1), cB + hstep, voffB); PG8_STAGE(PG8_SA(0, 0), cA, voffA); PG8_STAGE(PG8_SA(0, 1), cA + hstep, voffA);
        if (wr == 1) PG8_BAR;
        PG8_WAIT_V(2); PG8_BAR;
        PG8_STAGE(PG8_SB(1, 0), cB + kstep, voffB); PG8_STAGE(PG8_SA(1, 0), cA + kstep, voffA); PG8_STAGE(PG8_SB(1, 1), cB + hstep + kstep, voffB);
        PG8_WAIT_V(6); PG8_BAR;
    } else {
        PG8_STAGE(PG8_SB(0, 0), cB, voffB); PG8_STAGE(PG8_SA(0, 0), cA, voffA); PG8_STAGE(PG8_SB(0, 1), cB + hstep, voffB); PG8_STAGE(PG8_SA(0, 1), cA + hstep, voffA);
        if (wr == 1) PG8_BAR;
        PG8_WAIT_V(4); PG8_BAR;
        PG8_STAGE(PG8_SB(1, 0), cB + kstep, voffB); PG8_STAGE(PG8_SA(1, 0), cA + kstep, voffA); PG8_STAGE(PG8_SB(1, 1), cB + hstep + kstep, voffB);
        PG8_WAIT_V(6); PG8_BAR;
    }
    for (;;) {
        const bool has_next = S.next(ui + 1, nxt);
        const char* nA = has_next ? (const char*)g.A + (size_t)nxt.pm * tstep : cA; const char* nB = has_next ? (const char*)g.Bt + (size_t)nxt.pn * tstep : cB;
        for (int t = 0; t < nt; t += 2) {
            const bool last = (t == nt - 2);
            const char* a1 = cA + (size_t)(t + 1) * kstep;
            const char* a2 = last ? nA : cA + (size_t)(t + 2) * kstep; const char* b2 = last ? nB : cB + (size_t)(t + 2) * kstep;
            const char* a3 = a2 + kstep; const char* b3 = b2 + kstep;
            if (last && has_next) S.a_ready(nxt);
            if constexpr (SP2) {
            PG8_LDB(B0, 0, 0); PG8_LDB(B1, 0, 1); PG8_SCHED; PG8_LDA(At, 0, 0); PG8_STAGE(PG8_SA(1, 1), a1 + hstep, voffA);
            PG8_WAIT_V(8); PG8_WAIT_L(0); PG8_BAR; PG8_MMA(0, 0, At, B0); PG8_MMA(0, 1, At, B1); PG8_BAR; PG8_SCHED;
            PG8_LDA(At, 0, 1); PG8_STAGE(PG8_SB(0, 0), b2, voffB); PG8_STAGE(PG8_SB(0, 1), b2 + hstep, voffB); PG8_STAGE(PG8_SA(0, 0), a2, voffA);
            PG8_WAIT_V(8); PG8_WAIT_L(0); PG8_BAR; PG8_MMA(1, 0, At, B0); PG8_MMA(1, 1, At, B1); PG8_BAR; PG8_SCHED;
            PG8_LDB(B0, 1, 0); PG8_LDB(B1, 1, 1); PG8_SCHED; PG8_LDA(At, 1, 0); PG8_STAGE(PG8_SA(0, 1), a2 + hstep, voffA);
            PG8_WAIT_V(8); PG8_WAIT_L(0); PG8_BAR; PG8_MMA(0, 0, At, B0); PG8_MMA(0, 1, At, B1); PG8_BAR; PG8_SCHED;
            PG8_LDA(At, 1, 1); PG8_STAGE(PG8_SB(1, 0), b3, voffB); PG8_STAGE(PG8_SB(1, 1), b3 + hstep, voffB); PG8_STAGE(PG8_SA(1, 0), a3, voffA);
            PG8_WAIT_V(8); PG8_WAIT_L(0); PG8_BAR; PG8_MMA(1, 0, At, B0); PG8_MMA(1, 1, At, B1); PG8_BAR; PG8_SCHED;
            } else {
            PG8_LDB(B0, 0, 0); PG8_SCHED; PG8_LDA(At, 0, 0); PG8_STAGE(PG8_SA(1, 1), a1 + hstep, voffA);
            PG8_WAIT_L(8); PG8_BAR; PG8_WAIT_L(0); PG8_MMA(0, 0, At, B0); PG8_BAR; PG8_SCHED;
            PG8_LDB(B1, 0, 1); PG8_STAGE(PG8_SB(0, 0), b2, voffB);
            PG8_BAR; PG8_WAIT_L(0); PG8_MMA(0, 1, At, B1); PG8_BAR;
            PG8_LDA(At, 0, 1); PG8_STAGE(PG8_SA(0, 0), a2, voffA);
            PG8_BAR; PG8_WAIT_L(0); PG8_MMA(1, 0, At, B0); PG8_BAR; PG8_SCHED;
            PG8_STAGE(PG8_SB(0, 1), b2 + hstep, voffB);
            PG8_WAIT_V(6); PG8_BAR; PG8_MMA(1, 1, At, B1); PG8_BAR;
            PG8_LDB(B0, 1, 0); PG8_SCHED; PG8_LDA(At, 1, 0); PG8_STAGE(PG8_SA(0, 1), a2 + hstep, voffA);
            PG8_WAIT_L(8); PG8_BAR; PG8_WAIT_L(0); PG8_MMA(0, 0, At, B0); PG8_BAR; PG8_SCHED;
            PG8_LDB(B1, 1, 1); PG8_STAGE(PG8_SB(1, 0), b3, voffB);
            PG8_BAR; PG8_WAIT_L(0); PG8_MMA(0, 1, At, B1); PG8_BAR;
            PG8_LDA(At, 1, 1); PG8_STAGE(PG8_SA(1, 0), a3, voffA);
            PG8_BAR; PG8_WAIT_L(0); PG8_MMA(1, 0, At, B0); PG8_BAR; PG8_SCHED;
            PG8_STAGE(PG8_SB(1, 1), b3 + hstep, voffB);
            PG8_WAIT_V(6); PG8_BAR; PG8_MMA(1, 1, At, B1); PG8_BAR;
            }
        }
        if constexpr (ALIGN_EPI) { if (wr == 0) PG8_BAR; }
        if constexpr (!Epi::AFTER_DRAIN) { E(acc, cur, wr, wc, fr, fq); S.done(cur); }
        if (!has_next) break;
#pragma unroll
        for (int a = 0; a < 2; ++a)
#pragma unroll
            for (int b = 0; b < 2; ++b)
#pragma unroll
                for (int m = 0; m < 4; ++m)
#pragma unroll
                    for (int n = 0; n < 2; ++n) acc[a][b][m][n] = (f32x4){0.f, 0.f, 0.f, 0.f};
        cur = nxt; cA = nA; cB = nB; ++ui;
        if constexpr (ALIGN_EPI) { if (wr == 1) PG8_BAR; }
    }
    PG8_WAIT_V(0);
    if constexpr (!ALIGN_EPI) { if (wr == 0) PG8_BAR; }
    PG8_BAR;
    if constexpr (Epi::AFTER_DRAIN) { E.fused(acc, cur, wr, wc, fr, fq, lds, wid, lane); S.done(cur); }
#undef PG8_SA
#undef PG8_SB
#undef PG8_STAGE
#undef PG8_LDA
#undef PG8_LDB
#undef PG8_MMA
#undef PG8_WAIT_V
#undef PG8_WAIT_L
#undef PG8_BAR
#undef PG8_SCHED
}
}
#define GAS __attribute__((address_space(1)))
#define LAS __attribute__((address_space(3)))
typedef unsigned short bf16;
typedef unsigned v4u __attribute__((ext_vector_type(4)));
typedef float f32x4 __attribute__((ext_vector_type(4)));
typedef short bf16x8 __attribute__((ext_vector_type(8)));
typedef GAS unsigned gu32;
typedef GAS unsigned long long gu64;
#define RLX_AGENT __ATOMIC_RELAXED, __HIP_MEMORY_SCOPE_AGENT
#define LDS_WAIT() asm volatile("s_waitcnt lgkmcnt(0)" ::: "memory")
#define VM_WAIT() asm volatile("s_waitcnt vmcnt(0)" ::: "memory")
__device__ __forceinline__ unsigned long long rt() { return __builtin_amdgcn_s_memrealtime(); }

#define XB_TMO      128
#define XB_XCNT(j)  (256  + 64 * (j))
#define XB_XSUB(j)  (1280 + 64 * (j))
#define XB_XGEN(j)  (2304 + 64 * (j))
#define XB_TOP      3328
#define XB_TOPGEN   3392
#define XCD_BAR_WORDS 3456
#define XB_SPIN_CAP (1u << 18)

__device__ __forceinline__ unsigned xb_ld(unsigned* p)              { return __hip_atomic_load(p, __ATOMIC_RELAXED, __HIP_MEMORY_SCOPE_AGENT); }
__device__ __forceinline__ unsigned xb_add(unsigned* p, unsigned v) { return __hip_atomic_fetch_add(p, v, __ATOMIC_RELAXED, __HIP_MEMORY_SCOPE_AGENT); }
__device__ __forceinline__ unsigned xb_xcc_id() { return (unsigned)__builtin_amdgcn_s_getreg((3 << 11) | 20) & 0xFu; }
#define XB_SPIN(cond, bar) do { unsigned _sp = 0; while (cond) { __builtin_amdgcn_s_sleep(1); \
    if ((++_sp & 255u) == 0u) { if (xb_ld(&(bar)[XB_TMO])) break; if (_sp > XB_SPIN_CAP) { atomicAdd(&(bar)[XB_TMO], 1u); break; } } } } while (0)

struct XcdBarrier {
    unsigned* bar; unsigned x;
    volatile LAS unsigned* st;
};

__device__ __forceinline__ XcdBarrier xcd_barrier_post(unsigned* bar, volatile LAS unsigned* st) {
    XcdBarrier b; b.bar = bar; b.x = xb_xcc_id(); b.st = st;
    if (threadIdx.x == 0) (void)xb_add(&bar[XB_XCNT(b.x)], 1u);
    return b;
}
__device__ __forceinline__ void xcd_barrier_complete(unsigned* bar, unsigned x, unsigned& nloc, unsigned& nx) {
    const unsigned G = gridDim.x * gridDim.y * gridDim.z;
    unsigned sum, cnt, mine, sp = 0u;
    for (;;) {
        sum = 0u; cnt = 0u; mine = 0u;
#pragma unroll
        for (unsigned j = 0; j < 16; ++j) { const unsigned c = xb_ld(&bar[XB_XCNT(j)]); sum += c; cnt += (c > 0u) ? 1u : 0u; mine = (j == x) ? c : mine; }
        if (sum == G) break;
        __builtin_amdgcn_s_sleep(1);
        if ((++sp & 255u) == 0u) { if (xb_ld(&bar[XB_TMO])) break; if (sp > XB_SPIN_CAP) { atomicAdd(&bar[XB_TMO], 1u); break; } }
    }
    nloc = mine > 0u ? mine : 1u; nx = cnt > 0u ? cnt : 1u;
}

__device__ __forceinline__ void xcd_barrier(const XcdBarrier& b) {
    asm volatile("s_waitcnt vmcnt(0)" ::: "memory");
    __syncthreads();
    if (threadIdx.x == 0) {
        unsigned* bar = b.bar;
        __builtin_amdgcn_s_waitcnt(0);
        unsigned nloc = b.st[0], nx = b.st[1];
        if (nloc == 0u) { xcd_barrier_complete(bar, b.x, nloc, nx); b.st[0] = nloc; b.st[1] = nx; }
        const unsigned old = xb_add(&bar[XB_XSUB(b.x)], 1u);
        const unsigned gen = old / nloc;
        if (old + 1u == (gen + 1u) * nloc) {
            __builtin_amdgcn_fence(__ATOMIC_RELEASE, "agent");
            asm volatile("s_waitcnt vmcnt(0)" ::: "memory");
            const unsigned og = xb_add(&bar[XB_TOP], 1u);
            const unsigned tg = og / nx;
            if (og + 1u == (tg + 1u) * nx) xb_add(&bar[XB_TOPGEN], 1u);
            else XB_SPIN(xb_ld(&bar[XB_TOPGEN]) == tg, bar);
            __builtin_amdgcn_fence(__ATOMIC_ACQUIRE, "agent");
            xb_add(&bar[XB_XGEN(b.x)], 1u);
            asm volatile("s_waitcnt vmcnt(0)" ::: "memory");
        } else {
            XB_SPIN(xb_ld(&bar[XB_XGEN(b.x)]) == gen, bar);
            __builtin_amdgcn_fence(__ATOMIC_ACQUIRE, "agent");
            asm volatile("s_waitcnt vmcnt(0)" ::: "memory");
        }
    }
    __syncthreads();
}
constexpr int NWAVES = 8;
constexpr int BATCH = 2, SEQ = 8192, DM = 2048, M = BATCH * SEQ;
constexpr int FW = 1024, SW = 2048, NHEAD = 32, CONVCH = 3072, CHUNK = 128, NCHUNK = SEQ / CHUNK;
constexpr int N_IN = 11328, N_P1 = 7168;
constexpr int COL_DT = 7168, COL_GATE = 7232;
constexpr float LN_EPS = 1e-5f, LOG2E = 1.4426950408889634f;
constexpr float DN_ALPHA = 1.189207115002721f;

constexpr size_t MiB = 1u << 20;
constexpr size_t WS_CTL = 0, CTL_ZERO_BYTES = 1 * MiB;
constexpr size_t WS_TW = 1 * MiB;
constexpr size_t WS_F1C = WS_TW + 65536;
constexpr size_t WS_F1S = WS_F1C + 8192;
constexpr size_t WS_W3 = WS_F1S + 8192;
constexpr size_t WS_DEC = WS_W3 + 65536;
constexpr size_t WS_WMIX = WS_DEC + 32768;
constexpr size_t WS_WIN = 2 * MiB;
constexpr size_t WS_WBF = 47 * MiB;
constexpr size_t WS_WBS = 51 * MiB;
constexpr size_t WS_WOUT = 59 * MiB;
constexpr size_t WS_XB = 68 * MiB;
constexpr size_t WS_YPK = 132 * MiB;
constexpr size_t WS_SZF = 164 * MiB;
constexpr size_t WS_SZS = 196 * MiB;
constexpr size_t WS_XBC = 260 * MiB;
constexpr size_t WS_DT = 356 * MiB;
constexpr size_t WS_TP = 360 * MiB;
constexpr size_t WS_END = 424 * MiB;
static_assert(WS_WMIX + 262144 <= WS_WIN && WS_WIN + (size_t)N_IN * DM * 2 <= WS_WBF, "ws map");
constexpr int CW_BAR = 4096;

constexpr int LDS_BYTES = 163840;
constexpr int MISC_OFF = LDS_BYTES - 256;

typedef short s16x4 __attribute__((ext_vector_type(4)));
typedef unsigned v2u __attribute__((ext_vector_type(2)));
typedef float f32x2 __attribute__((ext_vector_type(2)));
#define MFMA16(a, b, c) __builtin_amdgcn_mfma_f32_16x16x32_bf16((a), (b), (c), 0, 0, 0)
__device__ __forceinline__ unsigned pk2(float lo, float hi) { return pg8::cvt_pk_bf16(lo, hi); }
__device__ __forceinline__ float bflo(unsigned w) { return __builtin_bit_cast(float, w << 16); }
__device__ __forceinline__ float bfhi(unsigned w) { return __builtin_bit_cast(float, w & 0xffff0000u); }
__device__ __forceinline__ float ex2(float v) { return __builtin_amdgcn_exp2f(v); }
__device__ __forceinline__ s16x4 trread(const LAS unsigned char* p) { return __builtin_bit_cast(s16x4, __builtin_amdgcn_ds_read_tr16_b64_v4i16((LAS s16x4*)p)); }
__device__ __forceinline__ bf16x8 frag_tr(const LAS unsigned char* img, int rs, int klo, int khi, int c0, int fr) {
    const int off = (fr >> 2) * rs + (c0 + 4 * (fr & 3)) * 2;
    const s16x4 lo = trread(img + klo * rs + off), hi = trread(img + khi * rs + off);
    return (bf16x8){lo[0], lo[1], lo[2], lo[3], hi[0], hi[1], hi[2], hi[3]};
}
__device__ __forceinline__ bf16x8 mk8(unsigned a, unsigned b, unsigned c, unsigned d) { return __builtin_bit_cast(bf16x8, (v4u){a, b, c, d}); }
__device__ __forceinline__ float wave_sum(float v) {
#pragma unroll
    for (int o = 1; o < 64; o <<= 1) v += __shfl_xor(v, o);
    return v;
}
__device__ __forceinline__ float wave_incl_scan(float v, int lane) {
#pragma unroll
    for (int o = 1; o < 64; o <<= 1) { const float t = __shfl_up(v, o); if (lane >= o) v += t; }
    return v;
}

struct Frame {
    LAS unsigned char* lds;
    volatile LAS unsigned* MISC;
    gu32* ctl;
    int tid, lane, wave, bid, G;
    const float* const* in;
    float* out; unsigned char* ws;
    __device__ __forceinline__ const float* x() const { return in[0]; }
    __device__ __forceinline__ const float* w_in() const { return in[1]; }
    __device__ __forceinline__ const float* b_gate() const { return in[2]; }
    __device__ __forceinline__ const float* conv_w() const { return in[3]; }
    __device__ __forceinline__ const float* conv_b() const { return in[4]; }
    __device__ __forceinline__ const float* dtb_f() const { return in[5]; }
    __device__ __forceinline__ const float* alog_f() const { return in[6]; }
    __device__ __forceinline__ const float* dtb_b() const { return in[7]; }
    __device__ __forceinline__ const float* alog_b() const { return in[8]; }
    __device__ __forceinline__ const float* d_skip() const { return in[9]; }
    __device__ __forceinline__ const float* norm_w() const { return in[10]; }
    __device__ __forceinline__ const float* fmix_w() const { return in[11]; }
    __device__ __forceinline__ const float* fmix_b() const { return in[12]; }
    __device__ __forceinline__ const float* w_bf() const { return in[13]; }
    __device__ __forceinline__ const float* w_bs() const { return in[14]; }
    __device__ __forceinline__ const float* w_out() const { return in[15]; }
    __device__ __forceinline__ const float* ln_g() const { return in[16]; }
    __device__ __forceinline__ const float* ln_b() const { return in[17]; }
    __device__ __forceinline__ float2* TW() const { return (float2*)(ws + WS_TW); }
    __device__ __forceinline__ bf16* F1C() const { return (bf16*)(ws + WS_F1C); }
    __device__ __forceinline__ bf16* F1S() const { return (bf16*)(ws + WS_F1S); }
    __device__ __forceinline__ bf16* W3() const { return (bf16*)(ws + WS_W3); }
    __device__ __forceinline__ bf16* WMIX() const { return (bf16*)(ws + WS_WMIX); }
    __device__ __forceinline__ float* DEC() const { return (float*)(ws + WS_DEC); }
    __device__ __forceinline__ bf16* WIN() const { return (bf16*)(ws + WS_WIN); }
    __device__ __forceinline__ bf16* WBF() const { return (bf16*)(ws + WS_WBF); }
    __device__ __forceinline__ bf16* WBS() const { return (bf16*)(ws + WS_WBS); }
    __device__ __forceinline__ bf16* WOUT() const { return (bf16*)(ws + WS_WOUT); }
    __device__ __forceinline__ bf16* XB() const { return (bf16*)(ws + WS_XB); }
    __device__ __forceinline__ bf16* YPK() const { return (bf16*)(ws + WS_YPK); }
    __device__ __forceinline__ bf16* SZF() const { return (bf16*)(ws + WS_SZF); }
    __device__ __forceinline__ bf16* SZS() const { return (bf16*)(ws + WS_SZS); }
    __device__ __forceinline__ bf16* XBC() const { return (bf16*)(ws + WS_XBC); }
    __device__ __forceinline__ bf16* TP() const { return (bf16*)(ws + WS_TP); }
    __device__ __forceinline__ float* DT() const { return (float*)(ws + WS_DT); }
    __device__ __forceinline__ bf16* ST() const { return (bf16*)out; }
};

__device__ __forceinline__ void p0_transpose_item(const float* W, int K, int N, bf16* WT, LAS float* scr, int kb, int nb, int lane) {
    const int k0 = 64 * kb, n0 = 32 * nb;
#pragma unroll 8
    for (int i = 0; i < 32; ++i) { const int kk = 2 * i + (lane >> 5); scr[kk * 33 + (lane & 31)] = W[(size_t)(k0 + kk) * N + n0 + (lane & 31)]; }
    LDS_WAIT(); asm volatile("" ::: "memory");
    const int c = lane & 7;
#pragma unroll
    for (int j = 0; j < 4; ++j) { const int n = (lane >> 3) + 8 * j; const LAS float* s = scr + (8 * c) * 33 + n;
        v4u o; o.x = pk2(s[0 * 33], s[1 * 33]); o.y = pk2(s[2 * 33], s[3 * 33]); o.z = pk2(s[4 * 33], s[5 * 33]); o.w = pk2(s[6 * 33], s[7 * 33]);
        *(v4u*)(WT + (size_t)(n0 + n) * K + k0 + 8 * c) = o; }
    LDS_WAIT(); asm volatile("" ::: "memory");
}
__device__ __forceinline__ void p0_prologue(Frame& F) {
    const int gw = F.bid * NWAVES + F.wave, NGW = F.G * NWAVES, gt = F.bid * 512 + F.tid, NGT = F.G * 512;
    for (int u = gt; u < M * DM / 8; u += NGT) { const f32x4 a = *(const f32x4*)(F.x() + (size_t)u * 8), b = *(const f32x4*)(F.x() + (size_t)u * 8 + 4);
        *(v4u*)(F.XB() + (size_t)u * 8) = (v4u){pk2(a[0], a[1]), pk2(a[2], a[3]), pk2(b[0], b[1]), pk2(b[2], b[3])}; }
    for (int i = gt; i < 8192; i += NGT) { float s, c; sincospif((float)i * (1.0f / 4096.0f), &s, &c); F.TW()[i] = make_float2(c, s); }
    for (int i = gt; i < 4096; i += NGT) { const int ka = i >> 6, na = i & 63; float s, c; sincospif((float)((ka * na) & 63) * (1.0f / 32.0f), &s, &c);
        F.F1C()[i] = (bf16)(pk2(c, 0.f) & 0xffffu); F.F1S()[i] = (bf16)(pk2(-s, 0.f) & 0xffffu); }
    for (int i = gt; i < 128 * 256; i += NGT) { const int kb = i >> 8, k = i & 255, nb = k >> 1, ri = k & 1; float s, c; sincospif((float)((kb * nb) & 127) * (1.0f / 64.0f), &s, &c);
        F.W3()[i] = (bf16)(pk2(ri ? s : c, 0.f) & 0xffffu); }
    for (int i = gt; i < 8 * 128 * 128; i += NGT) { const int c = i & 127, o = (i >> 7) & 127, g = i >> 14; const float* Wg = F.fmix_w() + (size_t)g * 16384;
        float v;
        if (c <= 64) { v = Wg[c * 128 + o]; if (c >= 1 && c <= 63) v += Wg[(128 - c) * 128 + o]; }
        else { const int k2 = c - 64; v = Wg[k2 * 128 + o] - Wg[(128 - k2) * 128 + o]; }
        F.WMIX()[i] = (bf16)(pk2(v, 0.f) & 0xffffu); }
    {
        LAS float* scr = (LAS float*)(F.lds + 65536 + F.wave * 8704);
        constexpr int NB_IN = (N_IN - 1024) / 32;
        constexpr int I_IN = 32 * NB_IN, I_BF = 16 * 64, I_BS = 32 * 64, I_OUT = 32 * 64;
        for (int it = gw; it < I_IN + I_BF + I_BS + I_OUT; it += NGW) {
            int r = it;
            if (r < I_IN) { p0_transpose_item(F.w_in(), DM, N_IN, F.WIN(), scr, r / NB_IN, 32 + r % NB_IN, F.lane); continue; } r -= I_IN;
            if (r < I_BF) { p0_transpose_item(F.w_bf(), FW, DM, F.WBF(), scr, r / 64, r % 64, F.lane); continue; } r -= I_BF;
            if (r < I_BS) { p0_transpose_item(F.w_bs(), SW, DM, F.WBS(), scr, r / 64, r % 64, F.lane); continue; } r -= I_BS;
            p0_transpose_item(F.w_out(), DM, DM, F.WOUT(), scr, r / 64, r % 64, F.lane);
        }
    }
    __syncthreads();
    {
        LAS float* tile = (LAS float*)F.lds;
        LAS float* ctab = (LAS float*)(F.lds + 33024);
        LAS float* stab = ctab + 128;
        LAS unsigned short* otile = (LAS unsigned short*)(F.lds + 34048);
        if (F.tid < 128) { float s, c; sincospif((float)F.tid * (1.0f / 64.0f), &s, &c); ctab[F.tid] = c * (1.0f / 1024.0f); stab[F.tid] = -s * (1.0f / 1024.0f); }
        for (int it = F.bid; it < 8 * 32; it += F.G) {
            const int g = it >> 5, k0 = (it & 31) * 64;
            __syncthreads();
            for (int i = F.tid; i < 64 * 128; i += 512) { const int kk = i >> 7, n2 = i & 127; tile[kk * 129 + n2] = F.w_in()[(size_t)(k0 + kk) * N_IN + g * 128 + n2]; }
            __syncthreads();
            const int kk = F.tid & 63;
            for (int ci = 0; ci < 16; ++ci) { const int c = (F.tid >> 6) + 8 * ci; const int cc = (c <= 64) ? c : c - 64; const LAS float* tab = (c <= 64) ? ctab : stab;
                float acc = 0.f;
#pragma unroll 8
                for (int n2 = 0; n2 < 128; ++n2) acc += tile[kk * 129 + n2] * tab[(n2 * cc) & 127];
                otile[c * 72 + kk] = (unsigned short)(pk2(acc, 0.f) & 0xffffu); }
            __syncthreads();
            for (int i = F.tid; i < 128 * 8; i += 512) { const int c = i >> 3, pc = i & 7;
                *(v4u*)(F.WIN() + (size_t)(g * 128 + c) * DM + k0 + pc * 8) = *(const LAS v4u*)(otile + c * 72 + pc * 8); }
        }
        __syncthreads();
    }
}

__device__ __forceinline__ float softplus(float v) { return fmaxf(v, 0.f) + log1pf(__expf(-fabsf(v))); }
__device__ __forceinline__ void p1b_dt(Frame& F) {
    const int fr = F.lane & 15, fq = F.lane >> 4, mt = F.wave >> 1, nt0 = 2 * (F.wave & 1);
    const bf16* WDT = F.WIN() + (size_t)COL_DT * DM;
    for (int rb = F.bid; rb < M / 64; rb += F.G) {
        const int r0 = rb * 64;
        f32x4 acc[2] = {{0.f, 0.f, 0.f, 0.f}, {0.f, 0.f, 0.f, 0.f}};
        const bf16* ap = F.XB() + (size_t)(r0 + 16 * mt + fr) * DM + 8 * fq;
        const bf16* bp0 = WDT + (size_t)(16 * nt0 + fr) * DM + 8 * fq;
        const bf16* bp1 = bp0 + (size_t)16 * DM;
#pragma unroll 8
        for (int ks = 0; ks < DM / 32; ++ks) { const bf16x8 a = *(const bf16x8*)(ap + 32 * ks), b0 = *(const bf16x8*)(bp0 + 32 * ks), b1 = *(const bf16x8*)(bp1 + 32 * ks);
            acc[0] = MFMA16(a, b0, acc[0]); acc[1] = MFMA16(a, b1, acc[1]); }
#pragma unroll
        for (int u = 0; u < 2; ++u) { const int n = 16 * (nt0 + u) + fr; const float bias = (n < 32) ? F.dtb_f()[n] : F.dtb_b()[n - 32];
#pragma unroll
            for (int j = 0; j < 4; ++j) F.DT()[(size_t)(r0 + 16 * mt + 4 * fq + j) * 64 + n] = softplus(acc[u][j] + bias); }
    }
}

__device__ __forceinline__ void p2a_fft1(Frame& F) {
    const int fr = F.lane & 15, fq = F.lane >> 4, w = F.wave;
    LAS unsigned char* YS = F.lds;
    LAS unsigned char* OUT = F.lds + 34816;
    bf16x8 fc[4][2], fs[4][2];
#pragma unroll
    for (int ni = 0; ni < 4; ++ni)
#pragma unroll
        for (int ks = 0; ks < 2; ++ks) { fc[ni][ks] = *(const bf16x8*)(F.F1C() + (16 * ni + fr) * 64 + 32 * ks + 8 * fq); fs[ni][ks] = *(const bf16x8*)(F.F1S() + (16 * ni + fr) * 64 + 32 * ks + 8 * fq); }
    for (int item = F.bid; item < 256; item += F.G) {
        const int b = item >> 7, nb = item & 127;
        float twc[4], tws[4];
#pragma unroll
        for (int ni = 0; ni < 4; ++ni) { const float2 t = F.TW()[(nb * (16 * ni + fr)) & 8191]; twc[ni] = t.x; tws[ni] = t.y; }
        for (int ch = 0; ch < 4; ++ch) {
#pragma unroll
            for (int i = 0; i < 4; ++i) { const int id = F.tid + 512 * i, row = id >> 5, pc = id & 31;
                *(LAS v4u*)(YS + row * 544 + pc * 16) = *(const v4u*)(F.YPK() + (size_t)(b * SEQ + 128 * row + nb) * FW + ch * 256 + pc * 8); }
            __syncthreads();
            f32x4 ar[2][4], ai[2][4];
#pragma unroll
            for (int mi = 0; mi < 2; ++mi)
#pragma unroll
                for (int ni = 0; ni < 4; ++ni) { ar[mi][ni] = (f32x4){0.f, 0.f, 0.f, 0.f}; ai[mi][ni] = (f32x4){0.f, 0.f, 0.f, 0.f}; }
#pragma unroll
            for (int ks = 0; ks < 2; ++ks)
#pragma unroll
                for (int mi = 0; mi < 2; ++mi) { const bf16x8 a = frag_tr(YS, 544, 32 * ks + 8 * fq, 32 * ks + 8 * fq + 4, 32 * w + 16 * mi, fr);
#pragma unroll
                    for (int ni = 0; ni < 4; ++ni) { ar[mi][ni] = MFMA16(a, fc[ni][ks], ar[mi][ni]); ai[mi][ni] = MFMA16(a, fs[ni][ks], ai[mi][ni]); } }
#pragma unroll
            for (int mi = 0; mi < 2; ++mi) { const int cl = 32 * w + 16 * mi + 4 * fq, gl = cl >> 7, cc = cl & 127;
#pragma unroll
                for (int ni = 0; ni < 4; ++ni) { const int ka = 16 * ni + fr; float r2[4], i2[4];
#pragma unroll
                    for (int j = 0; j < 4; ++j) { const float tr = ar[mi][ni][j], ti = ai[mi][ni][j]; float a = tr * twc[ni] + ti * tws[ni], bb = ti * twc[ni] - tr * tws[ni];
                        if (cc + j >= 65) { const float t = a; a = -bb; bb = t; }
                        r2[j] = a; i2[j] = bb; }
                    LAS unsigned char* o = OUT + ((ka * 2 + gl) * 2) * 256 + cc * 2;
                    *(LAS v2u*)o = (v2u){pk2(r2[0], r2[1]), pk2(r2[2], r2[3])};
                    *(LAS v2u*)(o + 256) = (v2u){pk2(i2[0], i2[1]), pk2(i2[2], i2[3])}; } }
            __syncthreads();
#pragma unroll
            for (int i = 0; i < 8; ++i) { const int id = F.tid + 512 * i, piece = id >> 4, off = (id & 15) * 16, ka = piece >> 2, gl = (piece >> 1) & 1, ri = piece & 1, g = ch * 2 + gl;
                *(v4u*)((unsigned char*)F.TP() + (((((size_t)(b * 64 + ka) * 8 + g) * 128 + nb) * 2 + ri) * 128) * 2 + off) = *(const LAS v4u*)(OUT + piece * 256 + off); }
            __syncthreads();
        }
    }
}

struct ConvW { float w[5][8]; float b[8]; };
__device__ __forceinline__ void conv_load_w(ConvW& cw, const float* conv_w, const float* conv_b, int col0) {
#pragma unroll
    for (int t = 0; t < 5; ++t) { const f32x4 a = *(const f32x4*)(conv_w + t * CONVCH + col0), b = *(const f32x4*)(conv_w + t * CONVCH + col0 + 4);
#pragma unroll
        for (int j = 0; j < 4; ++j) { cw.w[t][j] = a[j]; cw.w[t][4 + j] = b[j]; } }
    const f32x4 a = *(const f32x4*)(conv_b + col0), b = *(const f32x4*)(conv_b + col0 + 4);
#pragma unroll
    for (int j = 0; j < 4; ++j) { cw.b[j] = a[j]; cw.b[4 + j] = b[j]; }
}
__device__ __forceinline__ v4u conv8(const bf16* xb_, int t, int col0, const ConvW& cw) {
    float o[8];
#pragma unroll
    for (int j = 0; j < 8; ++j) o[j] = cw.b[j];
#pragma unroll
    for (int tap = 0; tap < 5; ++tap) { const int tt = t + tap - 2; const bool ok = (tt >= 0) && (tt < SEQ); const int tc = ok ? tt : t;
        const v4u r = *(const v4u*)(xb_ + (size_t)tc * CONVCH + col0); const float m = ok ? 1.f : 0.f;
        o[0] += cw.w[tap][0] * (m * bflo(r.x)); o[1] += cw.w[tap][1] * (m * bfhi(r.x)); o[2] += cw.w[tap][2] * (m * bflo(r.y)); o[3] += cw.w[tap][3] * (m * bfhi(r.y));
        o[4] += cw.w[tap][4] * (m * bflo(r.z)); o[5] += cw.w[tap][5] * (m * bfhi(r.z)); o[6] += cw.w[tap][6] * (m * bflo(r.w)); o[7] += cw.w[tap][7] * (m * bfhi(r.w)); }
#pragma unroll
    for (int j = 0; j < 8; ++j) o[j] = pg8::silu(o[j]);
    return (v4u){pk2(o[0], o[1]), pk2(o[2], o[3]), pk2(o[4], o[5]), pk2(o[6], o[7])};
}

constexpr int ST_HEAD_BYTES = 16384;
__device__ __forceinline__ size_t st_off(int dir, int b, int c, int hg) { return ((((size_t)(dir * 2 + b) * NCHUNK + c) * NHEAD + hg) * ST_HEAD_BYTES); }
__device__ __forceinline__ void p2b_states(Frame& F) {
    const int lane = F.lane, fr = lane & 15, fq = lane >> 4, w = F.wave;
    LAS unsigned char* BMi = F.lds;
    LAS unsigned char* XS = F.lds + 34816 + w * 6144;
    LAS float* TAB = (LAS float*)(F.lds + 34816 + 8 * 6144 + w * 1024);
    for (int it = F.bid; it < 512; it += F.G) {
        const int g = it & 3, c = (it >> 2) & 63, b = it >> 8, t0 = c * CHUNK, hg = g * 8 + w;
        const bf16* xb_ = F.XBC() + (size_t)b * SEQ * CONVCH;
        {
            const int chunk = F.tid & 15, col0 = 2048 + g * 128 + chunk * 8; ConvW cw; conv_load_w(cw, F.conv_w(), F.conv_b(), col0);
#pragma unroll
            for (int i = 0; i < 4; ++i) { const int t = (F.tid >> 4) + 32 * i; *(LAS v4u*)(BMi + t * 272 + chunk * 16) = conv8(xb_, t0 + t, col0, cw); }
        }
        {
            const float* dtp = F.DT() + (size_t)(b * SEQ + t0) * 64;
            const float df0 = dtp[lane * 64 + hg], df1 = dtp[(lane + 64) * 64 + hg], db0 = dtp[lane * 64 + 32 + hg], db1 = dtp[(lane + 64) * 64 + 32 + hg];
            const float Af = -__expf(F.alog_f()[hg]) * LOG2E, Ab = -__expf(F.alog_b()[hg]) * LOG2E;
            const float af0 = df0 * Af, af1 = df1 * Af, ab0 = db0 * Ab, ab1 = db1 * Ab;
            const float sf0 = wave_incl_scan(af0, lane), tf0 = __shfl(sf0, 63), sf1 = wave_incl_scan(af1, lane) + tf0, totf = __shfl(sf1, 63);
            const float sb0 = wave_incl_scan(ab0, lane), tb0 = __shfl(sb0, 63), sb1 = wave_incl_scan(ab1, lane) + tb0, totb = __shfl(sb1, 63);
            const float cb0 = totb - (sb0 - ab0), cb1 = totb - (sb1 - ab1);
            TAB[lane] = ex2(totf - sf0) * df0; TAB[64 + lane] = ex2(totf - sf1) * df1;
            TAB[128 + lane] = ex2(totb - cb0) * db0; TAB[192 + lane] = ex2(totb - cb1) * db1;
            if (lane == 0) { F.DEC()[((0 * 2 + b) * NCHUNK + c) * NHEAD + hg] = ex2(totf); F.DEC()[((1 * 2 + b) * NCHUNK + c) * NHEAD + hg] = ex2(totb); }
        }
        __syncthreads();
        for (int q = 0; q < 4; ++q) {
            {   const int chunk = lane & 1, col0 = g * 512 + w * 64 + q * 16 + chunk * 8; ConvW cw; conv_load_w(cw, F.conv_w(), F.conv_b(), col0);
#pragma unroll
                for (int i = 0; i < 4; ++i) { const int t = (lane >> 1) + 32 * i; *(LAS v4u*)(XS + t * 48 + chunk * 16) = conv8(xb_, t0 + t, col0, cw); } }
#pragma unroll
            for (int dir = 0; dir < 2; ++dir) {
                f32x4 acc[8];
#pragma unroll
                for (int mi = 0; mi < 8; ++mi) acc[mi] = (f32x4){0.f, 0.f, 0.f, 0.f};
#pragma unroll
                for (int ks = 0; ks < 4; ++ks) {
                    const v4u xr = __builtin_bit_cast(v4u, frag_tr(XS, 48, 32 * ks + 8 * fq, 32 * ks + 8 * fq + 4, 0, fr));
                    const f32x4 w0 = *(const LAS f32x4*)(TAB + dir * 128 + 32 * ks + 8 * fq), w1 = *(const LAS f32x4*)(TAB + dir * 128 + 32 * ks + 8 * fq + 4);
                    const bf16x8 bs = mk8(pk2(bflo(xr.x) * w0[0], bfhi(xr.x) * w0[1]), pk2(bflo(xr.y) * w0[2], bfhi(xr.y) * w0[3]), pk2(bflo(xr.z) * w1[0], bfhi(xr.z) * w1[1]), pk2(bflo(xr.w) * w1[2], bfhi(xr.w) * w1[3]));
#pragma unroll
                    for (int mi = 0; mi < 8; ++mi) { const bf16x8 a = frag_tr(BMi, 272, 32 * ks + 8 * fq, 32 * ks + 8 * fq + 4, 16 * mi, fr); acc[mi] = MFMA16(a, bs, acc[mi]); }
                }
                unsigned char* dst = (unsigned char*)F.ST() + st_off(dir, b, c, hg) + (size_t)(q * 4 * 64 + lane) * 16;
#pragma unroll
                for (int k2 = 0; k2 < 4; ++k2)
                    *(v4u*)(dst + k2 * 1024) = (v4u){pk2(acc[2 * k2][0], acc[2 * k2][1]), pk2(acc[2 * k2][2], acc[2 * k2][3]), pk2(acc[2 * k2 + 1][0], acc[2 * k2 + 1][1]), pk2(acc[2 * k2 + 1][2], acc[2 * k2 + 1][3])};
            }
        }
        __syncthreads();
    }
}

__device__ __forceinline__ void p3a_fft2(Frame& F) {
    const int lane = F.lane, fr = lane & 15, fq = lane >> 4, w = F.wave;
    LAS unsigned char* TB = F.lds;
    LAS unsigned char* WM = F.lds + 73728;
    int g_loaded = -1;
    for (int id = F.bid; id < 1024; id += F.G) {
        const int g = id & 7, ka = (id >> 3) & 63, b = id >> 9;
        __syncthreads();
        if (g != g_loaded) {
#pragma unroll
            for (int i = 0; i < 4; ++i) { const int u = F.tid + 512 * i, row = u >> 4, pc = u & 15; *(LAS v4u*)(WM + row * 272 + pc * 16) = *(const v4u*)(F.WMIX() + (size_t)g * 16384 + row * 128 + pc * 8); }
            g_loaded = g;
        }
        const bf16* src = F.TP() + ((size_t)(b * 64 + ka) * 8 + g) * 32768;
#pragma unroll
        for (int i = 0; i < 8; ++i) { const int u = F.tid + 512 * i, row = u >> 4, pc = u & 15; *(LAS v4u*)(TB + row * 288 + pc * 16) = *(const v4u*)(src + row * 128 + pc * 8); }
        __syncthreads();
        f32x4 d1[8];
#pragma unroll
        for (int ci = 0; ci < 8; ++ci) d1[ci] = (f32x4){0.f, 0.f, 0.f, 0.f};
#pragma unroll
        for (int ks = 0; ks < 8; ++ks) { const bf16x8 b1 = *(const bf16x8*)(F.W3() + (16 * w + fr) * 256 + 32 * ks + 8 * fq);
#pragma unroll
            for (int ci = 0; ci < 8; ++ci) { const bf16x8 a1 = frag_tr(TB, 288, 32 * ks + 8 * fq, 32 * ks + 8 * fq + 4, 16 * ci, fr); d1[ci] = MFMA16(a1, b1, d1[ci]); } }
        f32x4 d2[8];
#pragma unroll
        for (int oi = 0; oi < 8; ++oi) d2[oi] = (f32x4){0.f, 0.f, 0.f, 0.f};
#pragma unroll
        for (int k2 = 0; k2 < 4; ++k2) { const bf16x8 bf = mk8(pk2(d1[2 * k2][0], d1[2 * k2][1]), pk2(d1[2 * k2][2], d1[2 * k2][3]), pk2(d1[2 * k2 + 1][0], d1[2 * k2 + 1][1]), pk2(d1[2 * k2 + 1][2], d1[2 * k2 + 1][3]));
#pragma unroll
            for (int oi = 0; oi < 8; ++oi) { const LAS unsigned char* wp = WM + (16 * oi + fr) * 272 + (32 * k2 + 4 * fq) * 2; const v2u lo = *(const LAS v2u*)wp, hi = *(const LAS v2u*)(wp + 32);
                d2[oi] = MFMA16(mk8(lo.x, lo.y, hi.x, hi.y), bf, d2[oi]); } }
        const size_t token = (size_t)b * SEQ + ka + 64 * (16 * w + fr);
#pragma unroll
        for (int oi = 0; oi < 8; ++oi) { const int col = g * 128 + 16 * oi + 4 * fq; const f32x4 bias = *(const f32x4*)(F.fmix_b() + col); const v2u sz = *(const v2u*)(F.SZF() + token * FW + col);
            *(v2u*)(F.YPK() + token * FW + col) = (v2u){pk2((d2[oi][0] + bias[0]) * bflo(sz.x), (d2[oi][1] + bias[1]) * bfhi(sz.x)), pk2((d2[oi][2] + bias[2]) * bflo(sz.y), (d2[oi][3] + bias[3]) * bfhi(sz.y))}; }
    }
    __syncthreads();
}

__device__ __forceinline__ void p3b_scan(Frame& F) {
    for (int gid = F.bid * 512 + F.tid; gid < 131072; gid += F.G * 512) {
        const int unit = gid & 1023, h = (gid >> 10) & 31, b = (gid >> 15) & 1, dir = gid >> 16;
        float cr[8];
#pragma unroll
        for (int j = 0; j < 8; ++j) cr[j] = 0.f;
        for (int cb = 0; cb < NCHUNK; cb += 8) {
            v4u v[8]; float dc[8];
#pragma unroll
            for (int u = 0; u < 8; ++u) { const int c = dir ? (NCHUNK - 1 - (cb + u)) : (cb + u);
                v[u] = *(const v4u*)((const unsigned char*)F.ST() + st_off(dir, b, c, h) + (size_t)unit * 16); dc[u] = F.DEC()[((dir * 2 + b) * NCHUNK + c) * NHEAD + h]; }
#pragma unroll
            for (int u = 0; u < 8; ++u) { const int c = dir ? (NCHUNK - 1 - (cb + u)) : (cb + u);
                *(v4u*)((unsigned char*)F.ST() + st_off(dir, b, c, h) + (size_t)unit * 16) = (v4u){pk2(cr[0], cr[1]), pk2(cr[2], cr[3]), pk2(cr[4], cr[5]), pk2(cr[6], cr[7])};
                cr[0] = cr[0] * dc[u] + bflo(v[u].x); cr[1] = cr[1] * dc[u] + bfhi(v[u].x); cr[2] = cr[2] * dc[u] + bflo(v[u].y); cr[3] = cr[3] * dc[u] + bfhi(v[u].y);
                cr[4] = cr[4] * dc[u] + bflo(v[u].z); cr[5] = cr[5] * dc[u] + bfhi(v[u].z); cr[6] = cr[6] * dc[u] + bflo(v[u].w); cr[7] = cr[7] * dc[u] + bfhi(v[u].w); }
        }
    }
}

__device__ __forceinline__ void p4_ssd_out(Frame& F) {
    const int w = F.wave;
    LAS unsigned char* BMi = F.lds;
    LAS unsigned char* CMi = F.lds + 34816;
    LAS unsigned char* XS = F.lds + 69632 + w * 6144;
    LAS float* TAB = (LAS float*)(F.lds + 69632 + 49152 + w * 2048);
    LAS float* SSQ = (LAS float*)(F.lds + 69632 + 49152 + 16384);
    bf16* Y = F.TP();
#pragma unroll 1
    for (int it = F.bid; it < 512; it += F.G) {
        int lane_ = F.lane; asm volatile("" : "+v"(lane_));
        const int lane = lane_, fr = lane & 15, fq = lane >> 4;
        const int g = it & 3, c = (it >> 2) & 63, b = it >> 8, t0 = c * CHUNK, hg = g * 8 + w;
        const bf16* xb_ = F.XBC() + (size_t)b * SEQ * CONVCH;
        {
            const int chunk = F.tid & 31, isC = chunk >> 4, col0 = 2048 + isC * 512 + g * 128 + (chunk & 15) * 8; ConvW cw; conv_load_w(cw, F.conv_w(), F.conv_b(), col0);
            LAS unsigned char* dst = (isC ? CMi : BMi) + (chunk & 15) * 16;
#pragma unroll 2
            for (int i = 0; i < 8; ++i) { const int t = (F.tid >> 5) + 16 * i; *(LAS v4u*)(dst + t * 272) = conv8(xb_, t0 + t, col0, cw); }
        }
        {
            const float* dtp = F.DT() + (size_t)(b * SEQ + t0) * 64;
            const float df0 = dtp[lane * 64 + hg], df1 = dtp[(lane + 64) * 64 + hg], db0 = dtp[lane * 64 + 32 + hg], db1 = dtp[(lane + 64) * 64 + 32 + hg];
            const float Af = -__expf(F.alog_f()[hg]) * LOG2E, Ab = -__expf(F.alog_b()[hg]) * LOG2E;
            const float af0 = df0 * Af, af1 = df1 * Af, ab0 = db0 * Ab, ab1 = db1 * Ab;
            const float sf0 = wave_incl_scan(af0, lane), tf0 = __shfl(sf0, 63), sf1 = wave_incl_scan(af1, lane) + tf0;
            const float sb0 = wave_incl_scan(ab0, lane), tb0 = __shfl(sb0, 63), sb1 = wave_incl_scan(ab1, lane) + tb0, totb = __shfl(sb1, 63);
            TAB[lane] = sf0; TAB[64 + lane] = sf1; TAB[128 + lane] = totb - (sb0 - ab0); TAB[192 + lane] = totb - (sb1 - ab1);
            TAB[256 + lane] = df0; TAB[320 + lane] = df1; TAB[384 + lane] = db0; TAB[448 + lane] = db1;
        }
        __syncthreads();
        {
            f32x4 d1[8];
#pragma unroll
            for (int si = 0; si < 8; ++si) d1[si] = (f32x4){0.f, 0.f, 0.f, 0.f};
#pragma unroll 1
            for (int ks = 0; ks < 4; ++ks) {
                const bf16x8 b1 = *(const LAS bf16x8*)(CMi + (16 * w + fr) * 272 + (32 * ks + 8 * fq) * 2);
#pragma unroll
                for (int si = 0; si < 8; ++si) { const bf16x8 a1 = *(const LAS bf16x8*)(BMi + (16 * si + fr) * 272 + (32 * ks + 8 * fq) * 2); d1[si] = MFMA16(a1, b1, d1[si]); }
            }
            __syncthreads();
#pragma unroll
            for (int si = 0; si < 8; ++si) *(LAS v2u*)(BMi + (16 * w + fr) * 272 + (16 * si + 4 * fq) * 2) = (v2u){pk2(d1[si][0], d1[si][1]), pk2(d1[si][2], d1[si][3])};
        }
        bf16x8 XSf[4][4];
#pragma unroll
        for (int q = 0; q < 4; ++q) {
            {   const int chunk = lane & 1, col0 = g * 512 + w * 64 + q * 16 + chunk * 8; ConvW cw; conv_load_w(cw, F.conv_w(), F.conv_b(), col0);
#pragma unroll 1
                for (int i = 0; i < 4; ++i) { const int t = (lane >> 1) + 32 * i; *(LAS v4u*)(XS + t * 48 + chunk * 16) = conv8(xb_, t0 + t, col0, cw); } }
#pragma unroll
            for (int ks = 0; ks < 4; ++ks) XSf[q][ks] = frag_tr(XS, 48, 32 * ks + 4 * fq, 32 * ks + 16 + 4 * fq, 0, fr);
            __builtin_amdgcn_sched_barrier(0);
        }
        __syncthreads();
        const float dsk = F.d_skip()[hg];
#pragma unroll 1
        for (int tg = 0; tg < 4; ++tg) {
            int lane2_ = lane_; asm volatile("" : "+v"(lane2_));
            const int lane = lane2_, fr = lane & 15, fq = lane >> 4;
            const unsigned char* PF = (const unsigned char*)F.ST() + st_off(0, b, c, hg) + (size_t)lane * 16;
            const unsigned char* PB = (const unsigned char*)F.ST() + st_off(1, b, c, hg) + (size_t)lane * 16;
            bf16x8 Gf[2][4];
            {
                const int tA = 16 * (2 * tg) + fr, tB = tA + 16;
                const float cftA = TAB[tA], cbtA = TAB[128 + tA], cftB = TAB[tB], cbtB = TAB[128 + tB];
#pragma unroll
                for (int ks = 0; ks < 4; ++ks) { unsigned pkA[4], pkB[4];
#pragma unroll
                    for (int u = 0; u < 2; ++u) { const int si = 2 * ks + u;
                        const f32x4 cfs = *(const LAS f32x4*)(TAB + 16 * si + 4 * fq), cbs = *(const LAS f32x4*)(TAB + 128 + 16 * si + 4 * fq), dfs = *(const LAS f32x4*)(TAB + 256 + 16 * si + 4 * fq), dbs = *(const LAS f32x4*)(TAB + 384 + 16 * si + 4 * fq);
#pragma unroll
                        for (int tl = 0; tl < 2; ++tl) { const int t = tl ? tB : tA; const float cft = tl ? cftB : cftA, cbt = tl ? cbtB : cbtA; float gv[4];
                            const v2u cbr = *(const LAS v2u*)(BMi + t * 272 + (16 * si + 4 * fq) * 2); const float cbv[4] = {bflo(cbr.x), bfhi(cbr.x), bflo(cbr.y), bfhi(cbr.y)};
                            const int d0 = 16 * (si - 2 * tg - tl) + 4 * fq - fr;
#pragma unroll
                            for (int j = 0; j < 4; ++j) { const int d = d0 + j;
                                const float arg = (d < 0) ? (cft - cfs[j]) : (cbt - cbs[j]), sc = (d < 0) ? dfs[j] : dbs[j];
                                float e = ex2(fminf(arg, 0.f)) * sc; e = (d == 0) ? (dfs[j] + dbs[j]) : e;
                                gv[j] = cbv[j] * e + ((d == 0) ? dsk : 0.f); }
                            if (tl) { pkB[2 * u] = pk2(gv[0], gv[1]); pkB[2 * u + 1] = pk2(gv[2], gv[3]); } else { pkA[2 * u] = pk2(gv[0], gv[1]); pkA[2 * u + 1] = pk2(gv[2], gv[3]); } }
                    }
                    Gf[0][ks] = mk8(pkA[0], pkA[1], pkA[2], pkA[3]); Gf[1][ks] = mk8(pkB[0], pkB[1], pkB[2], pkB[3]);
                    __builtin_amdgcn_sched_barrier(0);
                }
            }
            __builtin_amdgcn_sched_barrier(0);
            f32x4 acc[4][2];
#pragma unroll
            for (int pi = 0; pi < 4; ++pi) { acc[pi][0] = (f32x4){0.f, 0.f, 0.f, 0.f}; acc[pi][1] = (f32x4){0.f, 0.f, 0.f, 0.f}; }
#pragma unroll
            for (int pi = 0; pi < 4; ++pi)
#pragma unroll
                for (int ks = 0; ks < 4; ++ks) { acc[pi][0] = MFMA16(XSf[pi][ks], Gf[0][ks], acc[pi][0]); acc[pi][1] = MFMA16(XSf[pi][ks], Gf[1][ks], acc[pi][1]); }
#pragma unroll
            for (int dir = 0; dir < 2; ++dir) {
                bf16x8 Cs[2][4];
#pragma unroll
                for (int tl = 0; tl < 2; ++tl) {
                    const int t = 16 * (2 * tg + tl) + fr; const float e = ex2(TAB[dir * 128 + t]);
#pragma unroll
                    for (int ks = 0; ks < 4; ++ks) {
                        const LAS unsigned char* cp = CMi + t * 272 + (32 * ks + 4 * fq) * 2; const v2u lo = *(const LAS v2u*)cp, hi = *(const LAS v2u*)(cp + 32);
                        Cs[tl][ks] = mk8(pk2(bflo(lo.x) * e, bfhi(lo.x) * e), pk2(bflo(lo.y) * e, bfhi(lo.y) * e), pk2(bflo(hi.x) * e, bfhi(hi.x) * e), pk2(bflo(hi.y) * e, bfhi(hi.y) * e));
                    }
                }
                const unsigned char* PS = dir ? PB : PF;
#pragma unroll
                for (int pi = 0; pi < 4; ++pi) {
#pragma unroll
                    for (int ks = 0; ks < 4; ++ks) { const bf16x8 sf = *(const bf16x8*)(PS + (pi * 4 + ks) * 1024); acc[pi][0] = MFMA16(sf, Cs[0][ks], acc[pi][0]); acc[pi][1] = MFMA16(sf, Cs[1][ks], acc[pi][1]); }
                    __builtin_amdgcn_sched_barrier(0);
                }
            }
            float ssq0 = 0.f, ssq1 = 0.f;
#pragma unroll
            for (int pi = 0; pi < 4; ++pi) {
                const int ch = hg * 64 + 16 * pi + 4 * fq;
                {   const size_t token = (size_t)b * SEQ + t0 + 16 * (2 * tg) + fr; const v2u sz = *(const v2u*)(F.SZS() + token * SW + ch);
                    const float h0 = acc[pi][0][0] * bflo(sz.x), h1 = acc[pi][0][1] * bfhi(sz.x), h2 = acc[pi][0][2] * bflo(sz.y), h3 = acc[pi][0][3] * bfhi(sz.y);
                    ssq0 += h0 * h0 + h1 * h1 + h2 * h2 + h3 * h3; *(v2u*)(Y + token * SW + ch) = (v2u){pk2(h0, h1), pk2(h2, h3)}; }
                {   const size_t token = (size_t)b * SEQ + t0 + 16 * (2 * tg + 1) + fr; const v2u sz = *(const v2u*)(F.SZS() + token * SW + ch);
                    const float h0 = acc[pi][1][0] * bflo(sz.x), h1 = acc[pi][1][1] * bfhi(sz.x), h2 = acc[pi][1][2] * bflo(sz.y), h3 = acc[pi][1][3] * bfhi(sz.y);
                    ssq1 += h0 * h0 + h1 * h1 + h2 * h2 + h3 * h3; *(v2u*)(Y + token * SW + ch) = (v2u){pk2(h0, h1), pk2(h2, h3)}; }
            }
            ssq0 += __shfl_xor(ssq0, 16); ssq0 += __shfl_xor(ssq0, 32); ssq1 += __shfl_xor(ssq1, 16); ssq1 += __shfl_xor(ssq1, 32);
            if (fq == 0) { SSQ[w * 128 + 16 * (2 * tg) + fr] = ssq0; SSQ[w * 128 + 16 * (2 * tg + 1) + fr] = ssq1; }
        }
        __syncthreads();
#pragma unroll
        for (int ti = 0; ti < 8; ++ti) {
            const int t = 16 * ti + fr; float tot = 0.f;
#pragma unroll
            for (int ww = 0; ww < 8; ++ww) tot += SSQ[ww * 128 + t];
            const float rs = 1.0f / sqrtf(tot * (1.0f / 512.0f) + LN_EPS);
            const size_t token = (size_t)b * SEQ + t0 + t;
#pragma unroll
            for (int pi = 0; pi < 4; ++pi) { const int ch = hg * 64 + 16 * pi + 4 * fq; const f32x4 nw = *(const f32x4*)(F.norm_w() + ch); bf16* yp = Y + token * SW + ch; const v2u hv = *(const v2u*)yp;
                *(v2u*)yp = (v2u){pk2(bflo(hv.x) * rs * nw[0], bfhi(hv.x) * rs * nw[1]), pk2(bflo(hv.y) * rs * nw[2], bfhi(hv.y) * rs * nw[3])}; }
        }
        __syncthreads();
    }
}

__device__ __forceinline__ void p7_layernorm(Frame& F) {
    const int gw = F.bid * NWAVES + F.wave, NGW = F.G * NWAVES;
    for (int m = gw; m < M; m += NGW) {
        f32x4* xr = (f32x4*)(F.out + (size_t)m * DM) + F.lane;
        f32x4 v[8]; float s = 0.f;
#pragma unroll
        for (int j = 0; j < 8; ++j) { v[j] = xr[64 * j]; s += (v[j][0] + v[j][1]) + (v[j][2] + v[j][3]); }
        const float mean = wave_sum(s) * (1.0f / DM); float s2 = 0.f;
#pragma unroll
        for (int j = 0; j < 8; ++j) { v[j] = v[j] - mean; s2 += (v[j][0] * v[j][0] + v[j][1] * v[j][1]) + (v[j][2] * v[j][2] + v[j][3] * v[j][3]); }
        const float rstd = 1.0f / sqrtf(wave_sum(s2) * (1.0f / DM) + LN_EPS);
#pragma unroll
        for (int j = 0; j < 8; ++j) { const f32x4 gg = *((const f32x4*)F.ln_g() + F.lane + 64 * j), bb = *((const f32x4*)F.ln_b() + F.lane + 64 * j); xr[64 * j] = v[j] * rstd * gg + bb; }
    }
}

struct Args { const float* in[18]; float* out; unsigned char* ws; int ph_lo, ph_hi; };
__global__ void __launch_bounds__(NWAVES * 64, 2) hybrid_fwd(Args args) {
    extern __shared__ __attribute__((aligned(16))) unsigned char lds[];
    Frame F;
    F.lds = (LAS unsigned char*)lds;
    F.MISC = (volatile LAS unsigned*)(F.lds + MISC_OFF);
    F.tid = threadIdx.x; F.lane = F.tid & 63; F.wave = __builtin_amdgcn_readfirstlane(F.tid >> 6);
    F.G = gridDim.x; F.bid = blockIdx.x;
    unsigned char* ws = args.ws;
    F.ctl = (gu32*)(ws + WS_CTL);
    F.in = args.in; F.out = args.out; F.ws = ws;
    for (int u = F.tid; u < 64; u += NWAVES * 64) ((LAS unsigned*)(F.lds + MISC_OFF))[u] = 0u;
    __syncthreads();
    XcdBarrier bar = xcd_barrier_post((unsigned*)(F.ctl + CW_BAR), F.MISC + 8);
    const int lo = args.ph_lo, hi = args.ph_hi;
#ifndef PHASE_MASK
#define PHASE_MASK 0xFF
#endif
#define IN(k) (((PHASE_MASK >> (k)) & 1) && lo <= (k) && (k) < hi)
#define SEAM(k) do { if (IN(k) && IN((k) + 1)) xcd_barrier(bar); } while (0)
    if (IN(0)) { p0_prologue(F); } SEAM(0);
    if (IN(1)) {
        pg8::Gemm gm{F.XB(), F.WIN(), M, N_P1, DM}; pg8::StaticOrder S; S.init(M, N_P1, F.G, F.bid);
        pg8::EpiInProj E{F.YPK(), F.SZF(), F.SZS(), F.XBC()};
        pg8::gemm_phase<pg8::EpiInProj, pg8::StaticOrder, true, true>(F.lds, gm, S, E);
        p1b_dt(F);
    } SEAM(1);
    if (IN(2)) { p2a_fft1(F); p2b_states(F); } SEAM(2);
    if (IN(3)) { p3a_fft2(F); p3b_scan(F); } SEAM(3);
    if (IN(4)) { p4_ssd_out(F); } SEAM(4);
    if (IN(5)) {
        bf16* S1 = F.XBC(); bf16* S2 = F.SZS(); bf16* Mb = F.XBC();
        pg8::StaticOrder S; S.init(M, DM, F.G, F.bid);
        { pg8::Gemm gm{F.XB(), F.WIN() + (size_t)COL_GATE * DM, M, DM, DM}; pg8::EpiGate E{S1, DM, F.b_gate()};
          pg8::gemm_phase<pg8::EpiGate, pg8::StaticOrder, true, true>(F.lds, gm, S, E); }
        { pg8::Gemm gm{F.YPK(), F.WBF(), M, DM, FW}; pg8::EpiMul<0> E{S1, nullptr, nullptr, DM};
          pg8::gemm_phase<pg8::EpiMul<0>, pg8::StaticOrder, true, true>(F.lds, gm, S, E); }
        { pg8::Gemm gm{F.XB(), F.WIN() + (size_t)(COL_GATE + DM) * DM, M, DM, DM}; pg8::EpiGate E{S2, DM, F.b_gate() + DM};
          pg8::gemm_phase<pg8::EpiGate, pg8::StaticOrder, true, true>(F.lds, gm, S, E); }
        { pg8::Gemm gm{F.TP(), F.WBS(), M, DM, SW}; pg8::EpiMul<1> E{S1, S2, Mb, DM};
          pg8::gemm_phase<pg8::EpiMul<1>, pg8::StaticOrder, true, true>(F.lds, gm, S, E); }
    } SEAM(5);
    if (IN(6)) {
        pg8::Gemm gm{F.XBC(), F.WOUT(), M, DM, DM}; pg8::StaticOrder S; S.init(M, DM, F.G, F.bid);
        pg8::EpiOut E{F.out, F.x(), DM, DN_ALPHA};
        pg8::gemm_phase<pg8::EpiOut, pg8::StaticOrder, true, true>(F.lds, gm, S, E);
    } SEAM(6);
    if (IN(7)) { p7_layernorm(F); }
#undef IN
#undef SEAM
}

#ifndef MK_CUTS
#define MK_CUTS 0
#endif
extern "C" void kernel_launch(void* const* d_in, const int* in_sizes, int n_in, void* d_out, int out_size, void* d_ws, size_t ws_size, hipStream_t stream) {
    static int grid = 0;
    if (grid == 0) {
        if (n_in != 18 || in_sizes[0] != M * DM || out_size != M * DM || ws_size < WS_END) { fprintf(stderr, "kernel_launch: unexpected shapes (n_in %d, in0 %d, out %d, ws %zu)\n", n_in, n_in > 0 ? in_sizes[0] : -1, out_size, ws_size); grid = -1; return; }
        int dev = 0, cus = 0, per_cu = 0;
        if (hipGetDevice(&dev) != hipSuccess || hipDeviceGetAttribute(&cus, hipDeviceAttributeMultiprocessorCount, dev) != hipSuccess) { grid = -1; return; }
        if (hipFuncSetAttribute((const void*)hybrid_fwd, hipFuncAttributeMaxDynamicSharedMemorySize, LDS_BYTES) != hipSuccess) { fprintf(stderr, "kernel_launch: hipFuncSetAttribute failed\n"); grid = -1; return; }
        if (hipOccupancyMaxActiveBlocksPerMultiprocessor(&per_cu, (const void*)hybrid_fwd, NWAVES * 64, LDS_BYTES) != hipSuccess || per_cu < 1) fprintf(stderr, "kernel_launch: occupancy query reports %d\n", per_cu);
        (void)hipGetLastError();
        grid = cus;
    }
    if (grid < 0) return;
    if (hipMemsetAsync((char*)d_ws + WS_CTL, 0, CTL_ZERO_BYTES, stream) != hipSuccess) { fprintf(stderr, "kernel_launch: memset failed\n"); return; }
    Args a{};
    for (int i = 0; i < 18; ++i) a.in[i] = (const float*)d_in[i];
    a.out = (float*)d_out; a.ws = (unsigned char*)d_ws;
#if MK_CUTS
    for (int p = 0; p < 8; ++p) { a.ph_lo = p; a.ph_hi = p + 1; hipLaunchKernelGGL(hybrid_fwd, dim3(grid), dim3(NWAVES * 64), LDS_BYTES, stream, a); }
#else
    a.ph_lo = 0; a.ph_hi = 8;
    hipLaunchKernelGGL(hybrid_fwd, dim3(grid), dim3(NWAVES * 64), LDS_BYTES, stream, a);
#endif
    const hipError_t le = hipPeekAtLastError();
    if (le != hipSuccess) fprintf(stderr, "kernel_launch: launch failed: %s\n", hipGetErrorName(le));
}
```

```cpp
#include <hip/hip_runtime.h>
#include <cstdio>
#include <cstdint>
namespace pg8 {
#define PG8_LAS __attribute__((address_space(3)))
typedef unsigned short bf16_t;
typedef short bf16x8 __attribute__((ext_vector_type(8)));
typedef float f32x4 __attribute__((ext_vector_type(4)));
typedef unsigned u32x4 __attribute__((ext_vector_type(4)));
constexpr int BM = 256, BK = 64, HALF = 128, HTB = HALF * BK * 2  , STAGE_BYTES = 8 * HTB, NXCD = 8, WGM = 8;

__host__ __device__ __forceinline__ int lds_byte(int r, int c) { const int st = (r >> 4) * 2 + (c >> 5), rr = r & 15, cc = c & 31, ob = rr * 64 + cc * 2; return st * 1024 + (ob ^ (((ob >> 9) & 1) << 5)); }
__host__ __device__ __forceinline__ void stage_rc(int b, int& R, int& C) { const int st = b / 1024, sb = b % 1024, swz = sb ^ (((sb >> 9) & 1) << 5); R = (st >> 1) * 16 + swz / 64; C = (st & 1) * 32 + (swz % 64) / 2; }
__host__ __device__ __forceinline__ int perm32(int rho) { const int n = rho >> 4, i = rho & 15; return 8 * (i >> 2) + 4 * n + (i & 3); }

struct Unit { int pm, pn; };
struct Gemm { const bf16_t* A; const bf16_t* Bt; int M, N, K; };

struct StaticOrder {
    int nM, nN, nwg, G, c;
    __host__ __device__ void init(int M, int N, int G_, int c_) { nM = M / BM; nN = N / BM; nwg = nM * nN; G = G_; c = c_; }
    __host__ __device__ bool next(int i, Unit& u) const {
        const long L = (long)i * G + c; if (L >= nwg) return false;
        int wgid = (int)L; { const int q = nwg / NXCD, r = nwg % NXCD, xcd = wgid % NXCD, off = wgid / NXCD; wgid = (xcd < r ? xcd * (q + 1) : r * (q + 1) + (xcd - r) * q) + off; }
        const int nig = WGM * nN, gid = wgid / nig, fm = gid * WGM, gsz = (nM - fm) < WGM ? (nM - fm) : WGM;
        u.pm = fm + ((wgid % nig) % gsz); u.pn = (wgid % nig) / gsz; return true;
    }
    __device__ __forceinline__ void a_ready(const Unit&) const {}
    __device__ __forceinline__ void done(const Unit&) const {}
};

typedef float cvt_f32x2 __attribute__((ext_vector_type(2))); typedef __bf16 cvt_bf16x2 __attribute__((ext_vector_type(2)));
__device__ __forceinline__ unsigned cvt_pk_bf16(float lo, float hi) { const cvt_f32x2 v = {lo, hi}; const cvt_bf16x2 b = __builtin_convertvector(v, cvt_bf16x2); return __builtin_bit_cast(unsigned, b); }
__device__ __forceinline__ float bflo(unsigned w) { return __builtin_bit_cast(float, w << 16); }
__device__ __forceinline__ float bfhi(unsigned w) { return __builtin_bit_cast(float, w & 0xffff0000u); }
__device__ __forceinline__ float sigm(float v) { return __builtin_amdgcn_rcpf(1.0f + __builtin_amdgcn_exp2f(-1.4426950408889634f * v)); }
__device__ __forceinline__ float silu(float v) { return v * sigm(v); }
__device__ __forceinline__ u32x4 pack8(const f32x4& v0, const f32x4& v1) { u32x4 w; w.x = cvt_pk_bf16(v0[0], v0[1]); w.y = cvt_pk_bf16(v0[2], v0[3]); w.z = cvt_pk_bf16(v1[0], v1[1]); w.w = cvt_pk_bf16(v1[2], v1[3]); return w; }
__device__ __forceinline__ void unpack8(const u32x4& w, f32x4& v0, f32x4& v1) { v0 = (f32x4){bflo(w.x), bfhi(w.x), bflo(w.y), bfhi(w.y)}; v1 = (f32x4){bflo(w.z), bfhi(w.z), bflo(w.w), bfhi(w.w)}; }

struct EpiInProj {
    static constexpr bool PERM = true, AFTER_DRAIN = false;
    bf16_t *ypk, *szf, *szs, *xbc;
    __device__ __forceinline__ void operator()(const f32x4 (&acc)[2][2][4][2], const Unit& u, int wr, int wc, int fr, int fq) const {
        const int pn = u.pn; bf16_t* base; int ldc, colt; bool act;
        if (pn < 4) { base = ypk; ldc = 1024; colt = pn * BM; act = false; }
        else if (pn < 8) { base = szf; ldc = 1024; colt = (pn - 4) * BM; act = true; }
        else if (pn < 16) { base = szs; ldc = 2048; colt = (pn - 8) * BM; act = true; }
        else { base = xbc; ldc = 3072; colt = (pn - 16) * BM; act = false; }
        const int row0 = u.pm * BM + wr * 64 + fr, col0 = colt + wc * 32 + 8 * fq;
#pragma unroll
        for (int ai = 0; ai < 2; ++ai)
#pragma unroll
            for (int m = 0; m < 4; ++m) { bf16_t* rowp = base + (size_t)(row0 + ai * HALF + m * 16) * ldc + col0;
#pragma unroll
                for (int bj = 0; bj < 2; ++bj) { f32x4 v0 = acc[ai][bj][m][0], v1 = acc[ai][bj][m][1];
                    if (act) {
#pragma unroll
                        for (int j = 0; j < 4; ++j) { v0[j] = silu(v0[j]); v1[j] = silu(v1[j]); } }
                    *(u32x4*)(rowp + bj * HALF) = pack8(v0, v1); } }
    }
};
struct EpiGate {
    static constexpr bool PERM = true, AFTER_DRAIN = false;
    bf16_t* S; int ldc; const float* bias;
    __device__ __forceinline__ void operator()(const f32x4 (&acc)[2][2][4][2], const Unit& u, int wr, int wc, int fr, int fq) const {
        const int row0 = u.pm * BM + wr * 64 + fr, col0 = u.pn * BM + wc * 32 + 8 * fq;
        f32x4 bv[2][2];
#pragma unroll
        for (int bj = 0; bj < 2; ++bj)
#pragma unroll
            for (int n = 0; n < 2; ++n) bv[bj][n] = *(const f32x4*)(bias + col0 + bj * HALF + 4 * n);
#pragma unroll
        for (int ai = 0; ai < 2; ++ai)
#pragma unroll
            for (int m = 0; m < 4; ++m) { bf16_t* rowp = S + (size_t)(row0 + ai * HALF + m * 16) * ldc + col0;
#pragma unroll
                for (int bj = 0; bj < 2; ++bj) { f32x4 v0 = acc[ai][bj][m][0] + bv[bj][0], v1 = acc[ai][bj][m][1] + bv[bj][1];
#pragma unroll
                    for (int j = 0; j < 4; ++j) { v0[j] = sigm(v0[j]); v1[j] = sigm(v1[j]); }
                    *(u32x4*)(rowp + bj * HALF) = pack8(v0, v1); } }
    }
};
template <int MODE> struct EpiMul {
    static constexpr bool PERM = true, AFTER_DRAIN = false;
    bf16_t* S1; const bf16_t* S2; bf16_t* O; int ldc;
    __device__ __forceinline__ void operator()(const f32x4 (&acc)[2][2][4][2], const Unit& u, int wr, int wc, int fr, int fq) const {
        const int row0 = u.pm * BM + wr * 64 + fr, col0 = u.pn * BM + wc * 32 + 8 * fq;
#pragma unroll
        for (int ai = 0; ai < 2; ++ai)
#pragma unroll
            for (int m = 0; m < 4; ++m) { const size_t off = (size_t)(row0 + ai * HALF + m * 16) * ldc + col0;
#pragma unroll
                for (int bj = 0; bj < 2; ++bj) {
                    f32x4 a0, a1; unpack8(*(const u32x4*)(S1 + off + bj * HALF), a0, a1);
                    if (MODE == 0) { *(u32x4*)(S1 + off + bj * HALF) = pack8(a0 * acc[ai][bj][m][0], a1 * acc[ai][bj][m][1]); }
                    else { f32x4 g0, g1; unpack8(*(const u32x4*)(S2 + off + bj * HALF), g0, g1);
                           *(u32x4*)(O + off + bj * HALF) = pack8(a0 + g0 * acc[ai][bj][m][0], a1 + g1 * acc[ai][bj][m][1]); } } }
    }
};
struct EpiOut {
    static constexpr bool PERM = false, AFTER_DRAIN = false;
    float* C; const float* X; int ldc; float alpha;
    __device__ __forceinline__ void operator()(const f32x4 (&acc)[2][2][4][2], const Unit& u, int wr, int wc, int fr, int fq) const {
        const int row0 = u.pm * BM + wr * 64 + fr, col0 = u.pn * BM + wc * 32 + 4 * fq;
#pragma unroll
        for (int ai = 0; ai < 2; ++ai)
#pragma unroll
            for (int m = 0; m < 4; ++m) { const size_t off = (size_t)(row0 + ai * HALF + m * 16) * ldc + col0;
#pragma unroll
                for (int bj = 0; bj < 2; ++bj)
#pragma unroll
                    for (int n = 0; n < 2; ++n) { const f32x4 xv = *(const f32x4*)(X + off + bj * HALF + n * 16);
                        *(f32x4*)(C + off + bj * HALF + n * 16) = xv * alpha + acc[ai][bj][m][n]; } }
    }
};
template <class Epi, class Sched, bool ALIGN_EPI = false, bool SP2 = false>
__device__ __forceinline__ void gemm_phase(PG8_LAS unsigned char* lds, const Gemm g, const Sched& S, const Epi& E) {
    const int tid = threadIdx.x, wid = __builtin_amdgcn_readfirstlane(tid >> 6), lane = tid & 63, wr = wid >> 2, wc = wid & 3, fr = lane & 15, fq = lane >> 4;
    const int K = g.K, nt = K / BK;
    unsigned voffA[2], voffB[2];
#pragma unroll
    for (int i = 0; i < 2; ++i) { int R, C; stage_rc(tid * 16 + i * 8192, R, C); const int Rb = Epi::PERM ? ((R & ~31) + perm32(R & 31)) : R;
        voffA[i] = (unsigned)(R * K + C) * 2u; voffB[i] = (unsigned)(Rb * K + C) * 2u; }
    const size_t kstep = (size_t)(BK * 2);
    const size_t hstep = (size_t)HALF * K * 2;
    const size_t tstep = 2 * hstep;
    const unsigned ldsw = (unsigned)wid * 1024u;
    const int aoff = lds_byte(wr * 64 + fr, fq * 8), boff = lds_byte(wc * 32 + fr, fq * 8);
#define PG8_SA(b, h) (((b) * 2 + (h)) * HTB)
#define PG8_SB(b, h) ((4 + (b) * 2 + (h)) * HTB)
#define PG8_STAGE(bufoff, gbase, voff) do { _Pragma("unroll") for (int _i = 0; _i < 2; ++_i) \
        __builtin_amdgcn_global_load_lds((const unsigned*)((const char*)(gbase) + (voff)[_i]), (PG8_LAS unsigned*)(lds + (bufoff) + ldsw + _i * 8192), 16, 0, 0); } while (0)
#define PG8_LDA(dst, b, h) do { _Pragma("unroll") for (int m = 0; m < 4; ++m) _Pragma("unroll") for (int k = 0; k < 2; ++k) dst[m][k] = *(const PG8_LAS bf16x8*)(lds + PG8_SA(b, h) + aoff + m * 2048 + k * 1024); } while (0)
#define PG8_LDB(dst, b, h) do { _Pragma("unroll") for (int n = 0; n < 2; ++n) _Pragma("unroll") for (int k = 0; k < 2; ++k) dst[n][k] = *(const PG8_LAS bf16x8*)(lds + PG8_SB(b, h) + boff + n * 2048 + k * 1024); } while (0)
#define PG8_MMA(ai, bj, At, Bt) do { __builtin_amdgcn_s_setprio(1); _Pragma("unroll") for (int m = 0; m < 4; ++m) _Pragma("unroll") for (int n = 0; n < 2; ++n) _Pragma("unroll") for (int k = 0; k < 2; ++k) \
        acc[ai][bj][m][n] = __builtin_amdgcn_mfma_f32_16x16x32_bf16(Bt[n][k], At[m][k], acc[ai][bj][m][n], 0, 0, 0); __builtin_amdgcn_s_setprio(0); } while (0)
#define PG8_WAIT_V(n) asm volatile("s_waitcnt vmcnt(" #n ")" ::: "memory")
#define PG8_WAIT_L(n) asm volatile("s_waitcnt lgkmcnt(" #n ")" ::: "memory")
#define PG8_BAR __builtin_amdgcn_s_barrier()
#define PG8_SCHED __builtin_amdgcn_sched_barrier(0)
    Unit cur, nxt; int ui = 0;
    if (!S.next(0, cur)) return;
    f32x4 acc[2][2][4][2];
#pragma unroll
    for (int a = 0; a < 2; ++a)
#pragma unroll
        for (int b = 0; b < 2; ++b)
#pragma unroll
            for (int m = 0; m < 4; ++m)
#pragma unroll
                for (int n = 0; n < 2; ++n) acc[a][b][m][n] = (f32x4){0.f, 0.f, 0.f, 0.f};
    bf16x8 At[4][2], B0[2][2], B1[2][2];
    const char* cA = (const char*)g.A + (size_t)cur.pm * tstep; const char* cB = (const char*)g.Bt + (size_t)cur.pn * tstep;
    S.a_ready(cur);
    if constexpr (SP2) {
        PG8_STAGE(PG8_SB(0, 0), cB, voffB); PG8_STAGE(PG8_SB(0, 1), cB + hstep, voffB); PG8_STAGE(PG8_SA(0, 0), cA, voffA); PG8_STAGE(PG8_SA(0, 1), cA + hstep, voffA);
        if (wr == 1) PG8_BAR;
        PG8_WAIT_V(2); PG8_BAR;
        PG8_STAGE(PG8_SB(1, 0), cB + kstep, voffB); PG8_STAGE(PG8_SA(1, 0), cA + kstep, voffA); PG8_STAGE(PG8_SB(1, 1), cB + hstep + kstep, voffB);
        PG8_WAIT_V(6); PG8_BAR;
    } else {
        PG8_STAGE(PG8_SB(0, 0), cB, voffB); PG8_STAGE(PG8_SA(0, 0), cA, voffA); PG8_STAGE(PG8_SB(0, 1), cB + hstep, voffB); PG8_STAGE(PG8_SA(0, 1), cA + hstep, voffA);
        if (wr == 1) PG8_BAR;
        PG8_WAIT_V(4); PG8_BAR;
        PG8_STAGE(PG8_SB(1, 0), cB + kstep, voffB); PG8_STAGE(PG8_SA(1, 0), cA + kstep, voffA); PG8_STAGE(PG8_SB(1, 1), cB + hstep + kstep, voffB);
        PG8_WAIT_V(6); PG8_BAR;
    }
    for (;;) {
        const bool has_next = S.next(ui + 1, nxt);
        const char* nA = has_next ? (const char*)g.A + (size_t)nxt.pm * tstep : cA; const char* nB = has_next ? (const char*)g.Bt + (size_t)nxt.pn * tstep : cB;
        for (int t = 0; t < nt; t += 2) {
            const bool last = (t == nt - 2);
            const char* a1 = cA + (size_t)(t + 1) * kstep;
            const char* a2 = last ? nA : cA + (size_t)(t + 2) * kstep; const char* b2 = last ? nB : cB + (size_t)(t + 2) * kstep;
            const char* a3 = a2 + kstep; const char* b3 = b2 + kstep;
            if (last && has_next) S.a_ready(nxt);
            if constexpr (SP2) {
            PG8_LDB(B0, 0, 0); PG8_LDB(B1, 0, 1); PG8_SCHED; PG8_LDA(At, 0, 0); PG8_STAGE(PG8_SA(1, 1), a1 + hstep, voffA);
            PG8_WAIT_V(8); PG8_WAIT_L(0); PG8_BAR; PG8_MMA(0, 0, At, B0); PG8_MMA(0, 1, At, B1); PG8_BAR; PG8_SCHED;
            PG8_LDA(At, 0, 1); PG8_STAGE(PG8_SB(0, 0), b2, voffB); PG8_STAGE(PG8_SB(0, 1), b2 + hstep, voffB); PG8_STAGE(PG8_SA(0, 0), a2, voffA);
            PG8_WAIT_V(8); PG8_WAIT_L(0); PG8_BAR; PG8_MMA(1, 0, At, B0); PG8_MMA(1, 1, At, B1); PG8_BAR; PG8_SCHED;
            PG8_LDB(B0, 1, 0); PG8_LDB(B1, 1, 1); PG8_SCHED; PG8_LDA(At, 1, 0); PG8_STAGE(PG8_SA(0, 1), a2 + hstep, voffA);
            PG8_WAIT_V(8); PG8_WAIT_L(0); PG8_BAR; PG8_MMA(0, 0, At, B0); PG8_MMA(0, 1, At, B1); PG8_BAR; PG8_SCHED;
            PG8_LDA(At, 1, 1); PG8_STAGE(PG8_SB(1, 0), b3, voffB); PG8_STAGE(PG8_SB(1, 1), b3 + hstep, voffB); PG8_STAGE(PG8_SA(1, 0), a3, voffA);
            PG8_WAIT_V(8); PG8_WAIT_L(0); PG8_BAR; PG8_MMA(1, 0, At, B0); PG8_MMA(1, 1, At, B1); PG8_BAR; PG8_SCHED;
            } else {
            PG8_LDB(B0, 0, 0); PG8_SCHED; PG8_LDA(At, 0, 0); PG8_STAGE(PG8_SA(1, 1), a1 + hstep, voffA);
            PG8_WAIT_L(8); PG8_BAR; PG8_WAIT_L(0); PG8_MMA(0, 0, At, B0); PG8_BAR; PG8_SCHED;
            PG8_LDB(B1, 0, 1); PG8_STAGE(PG8_SB(0, 0), b2, voffB);
            PG8_BAR; PG8_WAIT_L(0); PG8_MMA(0, 1, At, B1); PG8_BAR;
            PG8_LDA(At, 0, 1); PG8_STAGE(PG8_SA(0, 0), a2, voffA);
            PG8_BAR; PG8_WAIT_L(0); PG8_MMA(1, 0, At, B0); PG8_BAR; PG8_SCHED;
            PG8_STAGE(PG8_SB(0, 1), b2 + hstep, voffB);
            PG8_WAIT_V(6); PG8_BAR; PG8_MMA(1, 1, At, B1); PG8_BAR;
            PG8_LDB(B0, 1, 0); PG8_SCHED; PG8_LDA(At, 1, 0); PG8_STAGE(PG8_SA(0, 1), a2 + hstep, voffA);
            PG8_WAIT_L(8); PG8_BAR; PG8_WAIT_L(0); PG8_MMA(0, 0, At, B0); PG8_BAR; PG8_SCHED;
            PG8_LDB(B1, 1, 1); PG8_STAGE(PG8_SB(1, 0), b3, voffB);
            PG8_BAR; PG8_WAIT_L(0); PG8_MMA(0, 1, At, B1); PG8_BAR;
            PG8_LDA(At, 1, 1); PG8_STAGE(PG8_SA(1, 0), a3, voffA);
            PG8_BAR; PG8_WAIT_L(0); PG8_MMA(1, 0, At, B0); PG8_BAR; PG8_SCHED;
            PG8_STAGE(PG8_SB(1, 1), b3 + hstep, voffB);
            PG8_WAIT_V(6); PG8_BAR; PG8_MMA(1, 1, At, B1); PG8_BAR;
            }
        }
        if constexpr (ALIGN_EPI) { if (wr == 0) PG8_BAR; }
        if constexpr (!Epi::AFTER_DRAIN) { E(acc, cur, wr, wc, fr, fq); S.done(cur); }
        if (!has_next) break;
#pragma unroll
        for (int a = 0; a < 2; ++a)
#pragma unroll
            for (int b = 0; b < 2; ++b)
#pragma unroll
                for (int m = 0; m < 4; ++m)
#pragma unroll
                    for (int n = 0; n < 2; ++n) acc[a][b][m][n] = (f32x4){0.f, 0.f, 0.f, 0.f};
        cur = nxt; cA = nA; cB = nB; ++ui;
        if constexpr (ALIGN_EPI) { if (wr == 1) PG8_BAR; }
    }
    PG8_WAIT_V(0);
    if constexpr (!ALIGN_EPI) { if (wr == 0) PG8_BAR; }
    PG8_BAR;
    if constexpr (Epi::AFTER_DRAIN) { E.fused(acc, cur, wr, wc, fr, fq, lds, wid, lane); S.done(cur); }
#undef PG8_SA
#undef PG8_SB
#undef PG8_STAGE
#undef PG8_LDA
#undef PG8_LDB
#undef PG8_MMA
#undef PG8_WAIT_V
#undef PG8_WAIT_L
#undef PG8_BAR
#undef PG8_SCHED
}
}
#define GAS __attribute__((address_space(1)))
#define LAS __attribute__((address_space(3)))
typedef unsigned short bf16;
typedef unsigned v4u __attribute__((ext_vector_type(4)));
typedef float f32x4 __attribute__((ext_vector_type(4)));
typedef short bf16x8 __attribute__((ext_vector_type(8)));
typedef GAS unsigned gu32;
typedef GAS unsigned long long gu64;
#define RLX_AGENT __ATOMIC_RELAXED, __HIP_MEMORY_SCOPE_AGENT
#define LDS_WAIT() asm volatile("s_waitcnt lgkmcnt(0)" ::: "memory")
#define VM_WAIT() asm volatile("s_waitcnt vmcnt(0)" ::: "memory")
__device__ __forceinline__ unsigned long long rt() { return __builtin_amdgcn_s_memrealtime(); }

#define XB_TMO      128
#define XB_XCNT(j)  (256  + 64 * (j))
#define XB_XSUB(j)  (1280 + 64 * (j))
#define XB_XGEN(j)  (2304 + 64 * (j))
#define XB_TOP      3328
#define XB_TOPGEN   3392
#define XCD_BAR_WORDS 3456
#define XB_SPIN_CAP (1u << 18)

__device__ __forceinline__ unsigned xb_ld(unsigned* p)              { return __hip_atomic_load(p, __ATOMIC_RELAXED, __HIP_MEMORY_SCOPE_AGENT); }
__device__ __forceinline__ unsigned xb_add(unsigned* p, unsigned v) { return __hip_atomic_fetch_add(p, v, __ATOMIC_RELAXED, __HIP_MEMORY_SCOPE_AGENT); }
__device__ __forceinline__ unsigned xb_xcc_id() { return (unsigned)__builtin_amdgcn_s_getreg((3 << 11) | 20) & 0xFu; }
#define XB_SPIN(cond, bar) do { unsigned _sp = 0; while (cond) { __builtin_amdgcn_s_sleep(1); \
    if ((++_sp & 255u) == 0u) { if (xb_ld(&(bar)[XB_TMO])) break; if (_sp > XB_SPIN_CAP) { atomicAdd(&(bar)[XB_TMO], 1u); break; } } } } while (0)

struct XcdBarrier {
    unsigned* bar; unsigned x;
    volatile LAS unsigned* st;
};

__device__ __forceinline__ XcdBarrier xcd_barrier_post(unsigned* bar, volatile LAS unsigned* st) {
    XcdBarrier b; b.bar = bar; b.x = xb_xcc_id(); b.st = st;
    if (threadIdx.x == 0) (void)xb_add(&bar[XB_XCNT(b.x)], 1u);
    return b;
}
__device__ __forceinline__ void xcd_barrier_complete(unsigned* bar, unsigned x, unsigned& nloc, unsigned& nx) {
    const unsigned G = gridDim.x * gridDim.y * gridDim.z;
    unsigned sum, cnt, mine, sp = 0u;
    for (;;) {
        sum = 0u; cnt = 0u; mine = 0u;
#pragma unroll
        for (unsigned j = 0; j < 16; ++j) { const unsigned c = xb_ld(&bar[XB_XCNT(j)]); sum += c; cnt += (c > 0u) ? 1u : 0u; mine = (j == x) ? c : mine; }
        if (sum == G) break;
        __builtin_amdgcn_s_sleep(1);
        if ((++sp & 255u) == 0u) { if (xb_ld(&bar[XB_TMO])) break; if (sp > XB_SPIN_CAP) { atomicAdd(&bar[XB_TMO], 1u); break; } }
    }
    nloc = mine > 0u ? mine : 1u; nx = cnt > 0u ? cnt : 1u;
}

__device__ __forceinline__ void xcd_barrier(const XcdBarrier& b) {
    asm volatile("s_waitcnt vmcnt(0)" ::: "memory");
    __syncthreads();
    if (threadIdx.x == 0) {
        unsigned* bar = b.bar;
        __builtin_amdgcn_s_waitcnt(0);
        unsigned nloc = b.st[0], nx = b.st[1];
        if (nloc == 0u) { xcd_barrier_complete(bar, b.x, nloc, nx); b.st[0] = nloc; b.st[1] = nx; }
        const unsigned old = xb_add(&bar[XB_XSUB(b.x)], 1u);
        const unsigned gen = old / nloc;
        if (old + 1u == (gen + 1u) * nloc) {
            __builtin_amdgcn_fence(__ATOMIC_RELEASE, "agent");
            asm volatile("s_waitcnt vmcnt(0)" ::: "memory");
            const unsigned og = xb_add(&bar[XB_TOP], 1u);
            const unsigned tg = og / nx;
            if (og + 1u == (tg + 1u) * nx) xb_add(&bar[XB_TOPGEN], 1u);
            else XB_SPIN(xb_ld(&bar[XB_TOPGEN]) == tg, bar);
            __builtin_amdgcn_fence(__ATOMIC_ACQUIRE, "agent");
            xb_add(&bar[XB_XGEN(b.x)], 1u);
            asm volatile("s_waitcnt vmcnt(0)" ::: "memory");
        } else {
            XB_SPIN(xb_ld(&bar[XB_XGEN(b.x)]) == gen, bar);
            __builtin_amdgcn_fence(__ATOMIC_ACQUIRE, "agent");
            asm volatile("s_waitcnt vmcnt(0)" ::: "memory");
        }
    }
    __syncthreads();
}
constexpr int NWAVES = 8;
constexpr int BATCH = 2, SEQ = 8192, DM = 2048, M = BATCH * SEQ;
constexpr int FW = 1024, SW = 2048, NHEAD = 32, CONVCH = 3072, CHUNK = 128, NCHUNK = SEQ / CHUNK;
constexpr int N_IN = 11328, N_P1 = 7168;
constexpr int COL_DT = 7168, COL_GATE = 7232;
constexpr float LN_EPS = 1e-5f, LOG2E = 1.4426950408889634f;
constexpr float DN_ALPHA = 1.189207115002721f;

constexpr size_t MiB = 1u << 20;
constexpr size_t WS_CTL = 0, CTL_ZERO_BYTES = 1 * MiB;
constexpr size_t WS_TW = 1 * MiB;
constexpr size_t WS_F1C = WS_TW + 65536;
constexpr size_t WS_F1S = WS_F1C + 8192;
constexpr size_t WS_W3 = WS_F1S + 8192;
constexpr size_t WS_DEC = WS_W3 + 65536;
constexpr size_t WS_WMIX = WS_DEC + 32768;
constexpr size_t WS_WIN = 2 * MiB;
constexpr size_t WS_WBF = 47 * MiB;
constexpr size_t WS_WBS = 51 * MiB;
constexpr size_t WS_WOUT = 59 * MiB;
constexpr size_t WS_XB = 68 * MiB;
constexpr size_t WS_YPK = 132 * MiB;
constexpr size_t WS_SZF = 164 * MiB;
constexpr size_t WS_SZS = 196 * MiB;
constexpr size_t WS_XBC = 260 * MiB;
constexpr size_t WS_DT = 356 * MiB;
constexpr size_t WS_TP = 360 * MiB;
constexpr size_t WS_XSF = 424 * MiB;
constexpr size_t WS_END = 488 * MiB;
static_assert(WS_WMIX + 262144 <= WS_WIN && WS_WIN + (size_t)N_IN * DM * 2 <= WS_WBF, "ws map");
constexpr int CW_BAR = 4096;

constexpr int LDS_BYTES = 163840;
constexpr int MISC_OFF = LDS_BYTES - 256;

typedef short s16x4 __attribute__((ext_vector_type(4)));
typedef unsigned v2u __attribute__((ext_vector_type(2)));
typedef float f32x2 __attribute__((ext_vector_type(2)));
#define MFMA16(a, b, c) __builtin_amdgcn_mfma_f32_16x16x32_bf16((a), (b), (c), 0, 0, 0)
__device__ __forceinline__ unsigned pk2(float lo, float hi) { return pg8::cvt_pk_bf16(lo, hi); }
__device__ __forceinline__ float bflo(unsigned w) { return __builtin_bit_cast(float, w << 16); }
__device__ __forceinline__ float bfhi(unsigned w) { return __builtin_bit_cast(float, w & 0xffff0000u); }
__device__ __forceinline__ float ex2(float v) { return __builtin_amdgcn_exp2f(v); }
__device__ __forceinline__ s16x4 trread(const LAS unsigned char* p) { return __builtin_bit_cast(s16x4, __builtin_amdgcn_ds_read_tr16_b64_v4i16((LAS s16x4*)p)); }
__device__ __forceinline__ bf16x8 frag_tr(const LAS unsigned char* img, int rs, int klo, int khi, int c0, int fr) {
    const int off = (fr >> 2) * rs + (c0 + 4 * (fr & 3)) * 2;
    const s16x4 lo = trread(img + klo * rs + off), hi = trread(img + khi * rs + off);
    return (bf16x8){lo[0], lo[1], lo[2], lo[3], hi[0], hi[1], hi[2], hi[3]};
}
__device__ __forceinline__ bf16x8 mk8(unsigned a, unsigned b, unsigned c, unsigned d) { return __builtin_bit_cast(bf16x8, (v4u){a, b, c, d}); }
__device__ __forceinline__ float wave_sum(float v) {
#pragma unroll
    for (int o = 1; o < 64; o <<= 1) v += __shfl_xor(v, o);
    return v;
}
__device__ __forceinline__ float wave_incl_scan(float v, int lane) {
#pragma unroll
    for (int o = 1; o < 64; o <<= 1) { const float t = __shfl_up(v, o); if (lane >= o) v += t; }
    return v;
}

struct Frame {
    LAS unsigned char* lds;
    volatile LAS unsigned* MISC;
    gu32* ctl;
    int tid, lane, wave, bid, G;
    const float* const* in;
    float* out; unsigned char* ws;
    __device__ __forceinline__ const float* x() const { return in[0]; }
    __device__ __forceinline__ const float* w_in() const { return in[1]; }
    __device__ __forceinline__ const float* b_gate() const { return in[2]; }
    __device__ __forceinline__ const float* conv_w() const { return in[3]; }
    __device__ __forceinline__ const float* conv_b() const { return in[4]; }
    __device__ __forceinline__ const float* dtb_f() const { return in[5]; }
    __device__ __forceinline__ const float* alog_f() const { return in[6]; }
    __device__ __forceinline__ const float* dtb_b() const { return in[7]; }
    __device__ __forceinline__ const float* alog_b() const { return in[8]; }
    __device__ __forceinline__ const float* d_skip() const { return in[9]; }
    __device__ __forceinline__ const float* norm_w() const { return in[10]; }
    __device__ __forceinline__ const float* fmix_w() const { return in[11]; }
    __device__ __forceinline__ const float* fmix_b() const { return in[12]; }
    __device__ __forceinline__ const float* w_bf() const { return in[13]; }
    __device__ __forceinline__ const float* w_bs() const { return in[14]; }
    __device__ __forceinline__ const float* w_out() const { return in[15]; }
    __device__ __forceinline__ const float* ln_g() const { return in[16]; }
    __device__ __forceinline__ const float* ln_b() const { return in[17]; }
    __device__ __forceinline__ float2* TW() const { return (float2*)(ws + WS_TW); }
    __device__ __forceinline__ bf16* F1C() const { return (bf16*)(ws + WS_F1C); }
    __device__ __forceinline__ bf16* F1S() const { return (bf16*)(ws + WS_F1S); }
    __device__ __forceinline__ bf16* W3() const { return (bf16*)(ws + WS_W3); }
    __device__ __forceinline__ bf16* WMIX() const { return (bf16*)(ws + WS_WMIX); }
    __device__ __forceinline__ float* DEC() const { return (float*)(ws + WS_DEC); }
    __device__ __forceinline__ bf16* WIN() const { return (bf16*)(ws + WS_WIN); }
    __device__ __forceinline__ bf16* WBF() const { return (bf16*)(ws + WS_WBF); }
    __device__ __forceinline__ bf16* WBS() const { return (bf16*)(ws + WS_WBS); }
    __device__ __forceinline__ bf16* WOUT() const { return (bf16*)(ws + WS_WOUT); }
    __device__ __forceinline__ bf16* XB() const { return (bf16*)(ws + WS_XB); }
    __device__ __forceinline__ bf16* YPK() const { return (bf16*)(ws + WS_YPK); }
    __device__ __forceinline__ bf16* SZF() const { return (bf16*)(ws + WS_SZF); }
    __device__ __forceinline__ bf16* SZS() const { return (bf16*)(ws + WS_SZS); }
    __device__ __forceinline__ bf16* XBC() const { return (bf16*)(ws + WS_XBC); }
    __device__ __forceinline__ bf16* TP() const { return (bf16*)(ws + WS_TP); }
    __device__ __forceinline__ float* DT() const { return (float*)(ws + WS_DT); }
    __device__ __forceinline__ unsigned char* XSF() const { return ws + WS_XSF; }
    __device__ __forceinline__ bf16* ST() const { return (bf16*)out; }
};

__device__ __forceinline__ void p0_transpose_item(const float* W, int K, int N, bf16* WT, LAS float* scr, int kb, int nb, int lane) {
    const int k0 = 64 * kb, n0 = 32 * nb;
#pragma unroll 8
    for (int i = 0; i < 32; ++i) { const int kk = 2 * i + (lane >> 5); scr[kk * 33 + (lane & 31)] = W[(size_t)(k0 + kk) * N + n0 + (lane & 31)]; }
    LDS_WAIT(); asm volatile("" ::: "memory");
    const int c = lane & 7;
#pragma unroll
    for (int j = 0; j < 4; ++j) { const int n = (lane >> 3) + 8 * j; const LAS float* s = scr + (8 * c) * 33 + n;
        v4u o; o.x = pk2(s[0 * 33], s[1 * 33]); o.y = pk2(s[2 * 33], s[3 * 33]); o.z = pk2(s[4 * 33], s[5 * 33]); o.w = pk2(s[6 * 33], s[7 * 33]);
        *(v4u*)(WT + (size_t)(n0 + n) * K + k0 + 8 * c) = o; }
    LDS_WAIT(); asm volatile("" ::: "memory");
}
__device__ __forceinline__ void p0_prologue(Frame& F) {
    const int gw = F.bid * NWAVES + F.wave, NGW = F.G * NWAVES, gt = F.bid * 512 + F.tid, NGT = F.G * 512;
    for (int u = gt; u < M * DM / 8; u += NGT) { const f32x4 a = *(const f32x4*)(F.x() + (size_t)u * 8), b = *(const f32x4*)(F.x() + (size_t)u * 8 + 4);
        *(v4u*)(F.XB() + (size_t)u * 8) = (v4u){pk2(a[0], a[1]), pk2(a[2], a[3]), pk2(b[0], b[1]), pk2(b[2], b[3])}; }
    for (int i = gt; i < 8192; i += NGT) { float s, c; sincospif((float)i * (1.0f / 4096.0f), &s, &c); F.TW()[i] = make_float2(c, s); }
    for (int i = gt; i < 4096; i += NGT) { const int ka = i >> 6, na = i & 63; float s, c; sincospif((float)((ka * na) & 63) * (1.0f / 32.0f), &s, &c);
        F.F1C()[i] = (bf16)(pk2(c, 0.f) & 0xffffu); F.F1S()[i] = (bf16)(pk2(-s, 0.f) & 0xffffu); }
    for (int i = gt; i < 128 * 256; i += NGT) { const int kb = i >> 8, k = i & 255, nb = k >> 1, ri = k & 1; float s, c; sincospif((float)((kb * nb) & 127) * (1.0f / 64.0f), &s, &c);
        F.W3()[i] = (bf16)(pk2(ri ? s : c, 0.f) & 0xffffu); }
    for (int i = gt; i < 8 * 128 * 128; i += NGT) { const int c = i & 127, o = (i >> 7) & 127, g = i >> 14; const float* Wg = F.fmix_w() + (size_t)g * 16384;
        float v;
        if (c <= 64) { v = Wg[c * 128 + o]; if (c >= 1 && c <= 63) v += Wg[(128 - c) * 128 + o]; }
        else { const int k2 = c - 64; v = Wg[k2 * 128 + o] - Wg[(128 - k2) * 128 + o]; }
        F.WMIX()[i] = (bf16)(pk2(v, 0.f) & 0xffffu); }
    {
        LAS float* scr = (LAS float*)(F.lds + 65536 + F.wave * 8704);
        constexpr int NB_IN = (N_IN - 1024) / 32;
        constexpr int I_IN = 32 * NB_IN, I_BF = 16 * 64, I_BS = 32 * 64, I_OUT = 32 * 64;
        for (int it = gw; it < I_IN + I_BF + I_BS + I_OUT; it += NGW) {
            int r = it;
            if (r < I_IN) { p0_transpose_item(F.w_in(), DM, N_IN, F.WIN(), scr, r / NB_IN, 32 + r % NB_IN, F.lane); continue; } r -= I_IN;
            if (r < I_BF) { p0_transpose_item(F.w_bf(), FW, DM, F.WBF(), scr, r / 64, r % 64, F.lane); continue; } r -= I_BF;
            if (r < I_BS) { p0_transpose_item(F.w_bs(), SW, DM, F.WBS(), scr, r / 64, r % 64, F.lane); continue; } r -= I_BS;
            p0_transpose_item(F.w_out(), DM, DM, F.WOUT(), scr, r / 64, r % 64, F.lane);
        }
    }
    __syncthreads();
    {
        LAS float* tile = (LAS float*)F.lds;
        LAS float* ctab = (LAS float*)(F.lds + 33024);
        LAS float* stab = ctab + 128;
        LAS unsigned short* otile = (LAS unsigned short*)(F.lds + 34048);
        if (F.tid < 128) { float s, c; sincospif((float)F.tid * (1.0f / 64.0f), &s, &c); ctab[F.tid] = c * (1.0f / 1024.0f); stab[F.tid] = -s * (1.0f / 1024.0f); }
        for (int it = F.bid; it < 8 * 32; it += F.G) {
            const int g = it >> 5, k0 = (it & 31) * 64;
            __syncthreads();
            for (int i = F.tid; i < 64 * 128; i += 512) { const int kk = i >> 7, n2 = i & 127; tile[kk * 129 + n2] = F.w_in()[(size_t)(k0 + kk) * N_IN + g * 128 + n2]; }
            __syncthreads();
            const int kk = F.tid & 63;
            for (int ci = 0; ci < 16; ++ci) { const int c = (F.tid >> 6) + 8 * ci; const int cc = (c <= 64) ? c : c - 64; const LAS float* tab = (c <= 64) ? ctab : stab;
                float acc = 0.f;
#pragma unroll 8
                for (int n2 = 0; n2 < 128; ++n2) acc += tile[kk * 129 + n2] * tab[(n2 * cc) & 127];
                otile[c * 72 + kk] = (unsigned short)(pk2(acc, 0.f) & 0xffffu); }
            __syncthreads();
            for (int i = F.tid; i < 128 * 8; i += 512) { const int c = i >> 3, pc = i & 7;
                *(v4u*)(F.WIN() + (size_t)(g * 128 + c) * DM + k0 + pc * 8) = *(const LAS v4u*)(otile + c * 72 + pc * 8); }
        }
        __syncthreads();
    }
}

__device__ __forceinline__ float softplus(float v) { return fmaxf(v, 0.f) + log1pf(__expf(-fabsf(v))); }
__device__ __forceinline__ void p1b_dt(Frame& F) {
    const int fr = F.lane & 15, fq = F.lane >> 4, mt = F.wave >> 1, nt0 = 2 * (F.wave & 1);
    const bf16* WDT = F.WIN() + (size_t)COL_DT * DM;
    for (int rb = F.bid; rb < M / 64; rb += F.G) {
        const int r0 = rb * 64;
        f32x4 acc[2] = {{0.f, 0.f, 0.f, 0.f}, {0.f, 0.f, 0.f, 0.f}};
        const bf16* ap = F.XB() + (size_t)(r0 + 16 * mt + fr) * DM + 8 * fq;
        const bf16* bp0 = WDT + (size_t)(16 * nt0 + fr) * DM + 8 * fq;
        const bf16* bp1 = bp0 + (size_t)16 * DM;
#pragma unroll 8
        for (int ks = 0; ks < DM / 32; ++ks) { const bf16x8 a = *(const bf16x8*)(ap + 32 * ks), b0 = *(const bf16x8*)(bp0 + 32 * ks), b1 = *(const bf16x8*)(bp1 + 32 * ks);
            acc[0] = MFMA16(a, b0, acc[0]); acc[1] = MFMA16(a, b1, acc[1]); }
#pragma unroll
        for (int u = 0; u < 2; ++u) { const int n = 16 * (nt0 + u) + fr; const float bias = (n < 32) ? F.dtb_f()[n] : F.dtb_b()[n - 32];
#pragma unroll
            for (int j = 0; j < 4; ++j) F.DT()[(size_t)(r0 + 16 * mt + 4 * fq + j) * 64 + n] = softplus(acc[u][j] + bias); }
    }
}

__device__ __forceinline__ void p2a_fft1(Frame& F) {
    const int fr = F.lane & 15, fq = F.lane >> 4, w = F.wave;
    LAS unsigned char* YS = F.lds;
    LAS unsigned char* OUT = F.lds + 34816;
    bf16x8 fc[4][2], fs[4][2];
#pragma unroll
    for (int ni = 0; ni < 4; ++ni)
#pragma unroll
        for (int ks = 0; ks < 2; ++ks) { fc[ni][ks] = *(const bf16x8*)(F.F1C() + (16 * ni + fr) * 64 + 32 * ks + 8 * fq); fs[ni][ks] = *(const bf16x8*)(F.F1S() + (16 * ni + fr) * 64 + 32 * ks + 8 * fq); }
    for (int item = F.bid; item < 256; item += F.G) {
        const int b = item >> 7, nb = item & 127;
        float twc[4], tws[4];
#pragma unroll
        for (int ni = 0; ni < 4; ++ni) { const float2 t = F.TW()[(nb * (16 * ni + fr)) & 8191]; twc[ni] = t.x; tws[ni] = t.y; }
        for (int ch = 0; ch < 4; ++ch) {
#pragma unroll
            for (int i = 0; i < 4; ++i) { const int id = F.tid + 512 * i, row = id >> 5, pc = id & 31;
                *(LAS v4u*)(YS + row * 544 + pc * 16) = *(const v4u*)(F.YPK() + (size_t)(b * SEQ + 128 * row + nb) * FW + ch * 256 + pc * 8); }
            __syncthreads();
            f32x4 ar[2][4], ai[2][4];
#pragma unroll
            for (int mi = 0; mi < 2; ++mi)
#pragma unroll
                for (int ni = 0; ni < 4; ++ni) { ar[mi][ni] = (f32x4){0.f, 0.f, 0.f, 0.f}; ai[mi][ni] = (f32x4){0.f, 0.f, 0.f, 0.f}; }
#pragma unroll
            for (int ks = 0; ks < 2; ++ks)
#pragma unroll
                for (int mi = 0; mi < 2; ++mi) { const bf16x8 a = frag_tr(YS, 544, 32 * ks + 8 * fq, 32 * ks + 8 * fq + 4, 32 * w + 16 * mi, fr);
#pragma unroll
                    for (int ni = 0; ni < 4; ++ni) { ar[mi][ni] = MFMA16(a, fc[ni][ks], ar[mi][ni]); ai[mi][ni] = MFMA16(a, fs[ni][ks], ai[mi][ni]); } }
#pragma unroll
            for (int mi = 0; mi < 2; ++mi) { const int cl = 32 * w + 16 * mi + 4 * fq, gl = cl >> 7, cc = cl & 127;
#pragma unroll
                for (int ni = 0; ni < 4; ++ni) { const int ka = 16 * ni + fr; float r2[4], i2[4];
#pragma unroll
                    for (int j = 0; j < 4; ++j) { const float tr = ar[mi][ni][j], ti = ai[mi][ni][j]; float a = tr * twc[ni] + ti * tws[ni], bb = ti * twc[ni] - tr * tws[ni];
                        if (cc + j >= 65) { const float t = a; a = -bb; bb = t; }
                        r2[j] = a; i2[j] = bb; }
                    LAS unsigned char* o = OUT + ((ka * 2 + gl) * 2) * 256 + cc * 2;
                    *(LAS v2u*)o = (v2u){pk2(r2[0], r2[1]), pk2(r2[2], r2[3])};
                    *(LAS v2u*)(o + 256) = (v2u){pk2(i2[0], i2[1]), pk2(i2[2], i2[3])}; } }
            __syncthreads();
#pragma unroll
            for (int i = 0; i < 8; ++i) { const int id = F.tid + 512 * i, piece = id >> 4, off = (id & 15) * 16, ka = piece >> 2, gl = (piece >> 1) & 1, ri = piece & 1, g = ch * 2 + gl;
                *(v4u*)((unsigned char*)F.TP() + (((((size_t)(b * 64 + ka) * 8 + g) * 128 + nb) * 2 + ri) * 128) * 2 + off) = *(const LAS v4u*)(OUT + piece * 256 + off); }
            __syncthreads();
        }
    }
}

struct ConvW { float w[5][8]; float b[8]; };
__device__ __forceinline__ void conv_load_w(ConvW& cw, const float* conv_w, const float* conv_b, int col0) {
#pragma unroll
    for (int t = 0; t < 5; ++t) { const f32x4 a = *(const f32x4*)(conv_w + t * CONVCH + col0), b = *(const f32x4*)(conv_w + t * CONVCH + col0 + 4);
#pragma unroll
        for (int j = 0; j < 4; ++j) { cw.w[t][j] = a[j]; cw.w[t][4 + j] = b[j]; } }
    const f32x4 a = *(const f32x4*)(conv_b + col0), b = *(const f32x4*)(conv_b + col0 + 4);
#pragma unroll
    for (int j = 0; j < 4; ++j) { cw.b[j] = a[j]; cw.b[4 + j] = b[j]; }
}
__device__ __forceinline__ v4u conv8(const bf16* xb_, int t, int col0, const ConvW& cw) {
    float o[8];
#pragma unroll
    for (int j = 0; j < 8; ++j) o[j] = cw.b[j];
#pragma unroll
    for (int tap = 0; tap < 5; ++tap) { const int tt = t + tap - 2; const bool ok = (tt >= 0) && (tt < SEQ); const int tc = ok ? tt : t;
        const v4u r = *(const v4u*)(xb_ + (size_t)tc * CONVCH + col0); const float m = ok ? 1.f : 0.f;
        o[0] += cw.w[tap][0] * (m * bflo(r.x)); o[1] += cw.w[tap][1] * (m * bfhi(r.x)); o[2] += cw.w[tap][2] * (m * bflo(r.y)); o[3] += cw.w[tap][3] * (m * bfhi(r.y));
        o[4] += cw.w[tap][4] * (m * bflo(r.z)); o[5] += cw.w[tap][5] * (m * bfhi(r.z)); o[6] += cw.w[tap][6] * (m * bflo(r.w)); o[7] += cw.w[tap][7] * (m * bfhi(r.w)); }
#pragma unroll
    for (int j = 0; j < 8; ++j) o[j] = pg8::silu(o[j]);
    return (v4u){pk2(o[0], o[1]), pk2(o[2], o[3]), pk2(o[4], o[5]), pk2(o[6], o[7])};
}

template <int NT> __device__ __forceinline__ void conv_win(const bf16* xb_, int t_first, int col0, const ConvW& cw, v4u (&out)[NT]) {
    v4u r[NT + 4];
#pragma unroll
    for (int i = 0; i < NT + 4; ++i) { const int tt = t_first - 2 + i; const bool ok = (tt >= 0) && (tt < SEQ); const int tc = ok ? tt : t_first;
        const v4u v = *(const v4u*)(xb_ + (size_t)tc * CONVCH + col0); r[i] = ok ? v : (v4u){0u, 0u, 0u, 0u}; }
#pragma unroll
    for (int n = 0; n < NT; ++n) { float o[8];
#pragma unroll
        for (int j = 0; j < 8; ++j) o[j] = cw.b[j];
#pragma unroll
        for (int tap = 0; tap < 5; ++tap) { const v4u x = r[n + tap];
            o[0] += cw.w[tap][0] * bflo(x.x); o[1] += cw.w[tap][1] * bfhi(x.x); o[2] += cw.w[tap][2] * bflo(x.y); o[3] += cw.w[tap][3] * bfhi(x.y);
            o[4] += cw.w[tap][4] * bflo(x.z); o[5] += cw.w[tap][5] * bfhi(x.z); o[6] += cw.w[tap][6] * bflo(x.w); o[7] += cw.w[tap][7] * bfhi(x.w); }
#pragma unroll
        for (int j = 0; j < 8; ++j) o[j] = pg8::silu(o[j]);
        out[n] = (v4u){pk2(o[0], o[1]), pk2(o[2], o[3]), pk2(o[4], o[5]), pk2(o[6], o[7])}; }
}

constexpr int ST_HEAD_BYTES = 16384;
__device__ __forceinline__ size_t st_off(int dir, int b, int c, int hg) { return ((((size_t)(dir * 2 + b) * NCHUNK + c) * NHEAD + hg) * ST_HEAD_BYTES); }
__device__ __forceinline__ void p2b_states(Frame& F) {
    const int lane = F.lane, fr = lane & 15, fq = lane >> 4, w = F.wave;
    LAS unsigned char* BMi = F.lds;
    LAS unsigned char* XS = F.lds + 34816 + w * 6144;
    LAS float* TAB = (LAS float*)(F.lds + 34816 + 8 * 6144 + w * 1024);
    for (int it = F.bid; it < 512; it += F.G) {
        const int g = it & 3, c = (it >> 2) & 63, b = it >> 8, t0 = c * CHUNK, hg = g * 8 + w;
        const bf16* xb_ = F.XBC() + (size_t)b * SEQ * CONVCH;
        {
            const int chunk = F.tid & 15, col0 = 2048 + g * 128 + chunk * 8, tb = (F.tid >> 4) * 4; ConvW cw; conv_load_w(cw, F.conv_w(), F.conv_b(), col0);
            v4u o4[4]; conv_win<4>(xb_, t0 + tb, col0, cw, o4);
#pragma unroll
            for (int i = 0; i < 4; ++i) *(LAS v4u*)(BMi + (tb + i) * 272 + chunk * 16) = o4[i];
        }
        {
            const float* dtp = F.DT() + (size_t)(b * SEQ + t0) * 64;
            const float df0 = dtp[lane * 64 + hg], df1 = dtp[(lane + 64) * 64 + hg], db0 = dtp[lane * 64 + 32 + hg], db1 = dtp[(lane + 64) * 64 + 32 + hg];
            const float Af = -__expf(F.alog_f()[hg]) * LOG2E, Ab = -__expf(F.alog_b()[hg]) * LOG2E;
            const float af0 = df0 * Af, af1 = df1 * Af, ab0 = db0 * Ab, ab1 = db1 * Ab;
            const float sf0 = wave_incl_scan(af0, lane), tf0 = __shfl(sf0, 63), sf1 = wave_incl_scan(af1, lane) + tf0, totf = __shfl(sf1, 63);
            const float sb0 = wave_incl_scan(ab0, lane), tb0 = __shfl(sb0, 63), sb1 = wave_incl_scan(ab1, lane) + tb0, totb = __shfl(sb1, 63);
            const float cb0 = totb - (sb0 - ab0), cb1 = totb - (sb1 - ab1);
            TAB[lane] = ex2(totf - sf0) * df0; TAB[64 + lane] = ex2(totf - sf1) * df1;
            TAB[128 + lane] = ex2(totb - cb0) * db0; TAB[192 + lane] = ex2(totb - cb1) * db1;
            if (lane == 0) { F.DEC()[((0 * 2 + b) * NCHUNK + c) * NHEAD + hg] = ex2(totf); F.DEC()[((1 * 2 + b) * NCHUNK + c) * NHEAD + hg] = ex2(totb); }
        }
        __syncthreads();
        for (int q = 0; q < 4; ++q) {
            {   const int chunk = lane & 1, col0 = g * 512 + w * 64 + q * 16 + chunk * 8, tb = (lane >> 1) * 4; ConvW cw; conv_load_w(cw, F.conv_w(), F.conv_b(), col0);
                v4u o4[4]; conv_win<4>(xb_, t0 + tb, col0, cw, o4);
#pragma unroll
                for (int i = 0; i < 4; ++i) *(LAS v4u*)(XS + (tb + i) * 48 + chunk * 16) = o4[i]; }
            {
                unsigned char* xd = F.XSF() + ((((size_t)(b * NCHUNK + c) * NHEAD + hg) * 16 + q * 4) * 64 + lane) * 16;
#pragma unroll
                for (int ks = 0; ks < 4; ++ks) *(v4u*)(xd + ks * 1024) = __builtin_bit_cast(v4u, frag_tr(XS, 48, 32 * ks + 4 * fq, 32 * ks + 16 + 4 * fq, 0, fr)); }
#pragma unroll
            for (int dir = 0; dir < 2; ++dir) {
                f32x4 acc[8];
#pragma unroll
                for (int mi = 0; mi < 8; ++mi) acc[mi] = (f32x4){0.f, 0.f, 0.f, 0.f};
#pragma unroll
                for (int ks = 0; ks < 4; ++ks) {
                    const v4u xr = __builtin_bit_cast(v4u, frag_tr(XS, 48, 32 * ks + 8 * fq, 32 * ks + 8 * fq + 4, 0, fr));
                    const f32x4 w0 = *(const LAS f32x4*)(TAB + dir * 128 + 32 * ks + 8 * fq), w1 = *(const LAS f32x4*)(TAB + dir * 128 + 32 * ks + 8 * fq + 4);
                    const bf16x8 bs = mk8(pk2(bflo(xr.x) * w0[0], bfhi(xr.x) * w0[1]), pk2(bflo(xr.y) * w0[2], bfhi(xr.y) * w0[3]), pk2(bflo(xr.z) * w1[0], bfhi(xr.z) * w1[1]), pk2(bflo(xr.w) * w1[2], bfhi(xr.w) * w1[3]));
#pragma unroll
                    for (int mi = 0; mi < 8; ++mi) { const bf16x8 a = frag_tr(BMi, 272, 32 * ks + 8 * fq, 32 * ks + 8 * fq + 4, 16 * mi, fr); acc[mi] = MFMA16(a, bs, acc[mi]); }
                }
                unsigned char* dst = (unsigned char*)F.ST() + st_off(dir, b, c, hg) + (size_t)(q * 4 * 64 + lane) * 16;
#pragma unroll
                for (int k2 = 0; k2 < 4; ++k2)
                    *(v4u*)(dst + k2 * 1024) = (v4u){pk2(acc[2 * k2][0], acc[2 * k2][1]), pk2(acc[2 * k2][2], acc[2 * k2][3]), pk2(acc[2 * k2 + 1][0], acc[2 * k2 + 1][1]), pk2(acc[2 * k2 + 1][2], acc[2 * k2 + 1][3])};
            }
        }
        __syncthreads();
    }
}

__device__ __forceinline__ void p3a_fft2(Frame& F) {
    const int lane = F.lane, fr = lane & 15, fq = lane >> 4, w = F.wave;
    LAS unsigned char* TB = F.lds;
    LAS unsigned char* WM = F.lds + 73728;
    int g_loaded = -1;
    for (int id = F.bid; id < 1024; id += F.G) {
        const int g = id & 7, ka = (id >> 3) & 63, b = id >> 9;
        __syncthreads();
        if (g != g_loaded) {
#pragma unroll
            for (int i = 0; i < 4; ++i) { const int u = F.tid + 512 * i, row = u >> 4, pc = u & 15; *(LAS v4u*)(WM + row * 272 + pc * 16) = *(const v4u*)(F.WMIX() + (size_t)g * 16384 + row * 128 + pc * 8); }
            g_loaded = g;
        }
        const bf16* src = F.TP() + ((size_t)(b * 64 + ka) * 8 + g) * 32768;
#pragma unroll
        for (int i = 0; i < 8; ++i) { const int u = F.tid + 512 * i, row = u >> 4, pc = u & 15; *(LAS v4u*)(TB + row * 288 + pc * 16) = *(const v4u*)(src + row * 128 + pc * 8); }
        __syncthreads();
        f32x4 d1[8];
#pragma unroll
        for (int ci = 0; ci < 8; ++ci) d1[ci] = (f32x4){0.f, 0.f, 0.f, 0.f};
#pragma unroll
        for (int ks = 0; ks < 8; ++ks) { const bf16x8 b1 = *(const bf16x8*)(F.W3() + (16 * w + fr) * 256 + 32 * ks + 8 * fq);
#pragma unroll
            for (int ci = 0; ci < 8; ++ci) { const bf16x8 a1 = frag_tr(TB, 288, 32 * ks + 8 * fq, 32 * ks + 8 * fq + 4, 16 * ci, fr); d1[ci] = MFMA16(a1, b1, d1[ci]); } }
        f32x4 d2[8];
#pragma unroll
        for (int oi = 0; oi < 8; ++oi) d2[oi] = (f32x4){0.f, 0.f, 0.f, 0.f};
#pragma unroll
        for (int k2 = 0; k2 < 4; ++k2) { const bf16x8 bf = mk8(pk2(d1[2 * k2][0], d1[2 * k2][1]), pk2(d1[2 * k2][2], d1[2 * k2][3]), pk2(d1[2 * k2 + 1][0], d1[2 * k2 + 1][1]), pk2(d1[2 * k2 + 1][2], d1[2 * k2 + 1][3]));
#pragma unroll
            for (int oi = 0; oi < 8; ++oi) { const LAS unsigned char* wp = WM + (16 * oi + fr) * 272 + (32 * k2 + 4 * fq) * 2; const v2u lo = *(const LAS v2u*)wp, hi = *(const LAS v2u*)(wp + 32);
                d2[oi] = MFMA16(mk8(lo.x, lo.y, hi.x, hi.y), bf, d2[oi]); } }
        const size_t token = (size_t)b * SEQ + ka + 64 * (16 * w + fr);
#pragma unroll
        for (int oi = 0; oi < 8; ++oi) { const int col = g * 128 + 16 * oi + 4 * fq; const f32x4 bias = *(const f32x4*)(F.fmix_b() + col); const v2u sz = *(const v2u*)(F.SZF() + token * FW + col);
            *(v2u*)(F.YPK() + token * FW + col) = (v2u){pk2((d2[oi][0] + bias[0]) * bflo(sz.x), (d2[oi][1] + bias[1]) * bfhi(sz.x)), pk2((d2[oi][2] + bias[2]) * bflo(sz.y), (d2[oi][3] + bias[3]) * bfhi(sz.y))}; }
    }
    __syncthreads();
}

__device__ __forceinline__ void p3b_scan(Frame& F) {
    for (int gid = F.bid * 512 + F.tid; gid < 131072; gid += F.G * 512) {
        const int unit = gid & 1023, h = (gid >> 10) & 31, b = (gid >> 15) & 1, dir = gid >> 16;
        float cr[8];
#pragma unroll
        for (int j = 0; j < 8; ++j) cr[j] = 0.f;
        for (int cb = 0; cb < NCHUNK; cb += 8) {
            v4u v[8]; float dc[8];
#pragma unroll
            for (int u = 0; u < 8; ++u) { const int c = dir ? (NCHUNK - 1 - (cb + u)) : (cb + u);
                v[u] = *(const v4u*)((const unsigned char*)F.ST() + st_off(dir, b, c, h) + (size_t)unit * 16); dc[u] = F.DEC()[((dir * 2 + b) * NCHUNK + c) * NHEAD + h]; }
#pragma unroll
            for (int u = 0; u < 8; ++u) { const int c = dir ? (NCHUNK - 1 - (cb + u)) : (cb + u);
                *(v4u*)((unsigned char*)F.ST() + st_off(dir, b, c, h) + (size_t)unit * 16) = (v4u){pk2(cr[0], cr[1]), pk2(cr[2], cr[3]), pk2(cr[4], cr[5]), pk2(cr[6], cr[7])};
                cr[0] = cr[0] * dc[u] + bflo(v[u].x); cr[1] = cr[1] * dc[u] + bfhi(v[u].x); cr[2] = cr[2] * dc[u] + bflo(v[u].y); cr[3] = cr[3] * dc[u] + bfhi(v[u].y);
                cr[4] = cr[4] * dc[u] + bflo(v[u].z); cr[5] = cr[5] * dc[u] + bfhi(v[u].z); cr[6] = cr[6] * dc[u] + bflo(v[u].w); cr[7] = cr[7] * dc[u] + bfhi(v[u].w); }
        }
    }
}

__device__ __forceinline__ void p4_ssd_out(Frame& F) {
    const int w = F.wave;
    LAS unsigned char* BMi = F.lds;
    LAS unsigned char* CMi = F.lds + 34816;
    LAS float* TAB = (LAS float*)(F.lds + 69632 + w * 2048);
    LAS float* SSQ = (LAS float*)(F.lds + 69632 + 16384);
    bf16* Y = F.TP();
#pragma unroll 1
    for (int it = F.bid; it < 512; it += F.G) {
        int lane_ = F.lane; asm volatile("" : "+v"(lane_));
        const int lane = lane_, fr = lane & 15, fq = lane >> 4;
        const int g = it & 3, c = (it >> 2) & 63, b = it >> 8, t0 = c * CHUNK, hg = g * 8 + w;
        const bf16* xb_ = F.XBC() + (size_t)b * SEQ * CONVCH;
        bf16x8 XSf[4][4];
        {   const unsigned char* xsrc = F.XSF() + (((size_t)(b * NCHUNK + c) * NHEAD + hg) * 16 * 64 + lane) * 16;
#pragma unroll
            for (int q = 0; q < 4; ++q)
#pragma unroll
                for (int ks = 0; ks < 4; ++ks) XSf[q][ks] = *(const bf16x8*)(xsrc + (q * 4 + ks) * 1024); }
        {
            const int chunk = F.tid & 31, isC = chunk >> 4, col0 = 2048 + isC * 512 + g * 128 + (chunk & 15) * 8, tb = (F.tid >> 5) * 8; ConvW cw; conv_load_w(cw, F.conv_w(), F.conv_b(), col0);
            LAS unsigned char* dst = (isC ? CMi : BMi) + (chunk & 15) * 16;
            v4u o8[8]; conv_win<8>(xb_, t0 + tb, col0, cw, o8);
#pragma unroll
            for (int i = 0; i < 8; ++i) *(LAS v4u*)(dst + (tb + i) * 272) = o8[i];
        }
        {
            const float* dtp = F.DT() + (size_t)(b * SEQ + t0) * 64;
            const float df0 = dtp[lane * 64 + hg], df1 = dtp[(lane + 64) * 64 + hg], db0 = dtp[lane * 64 + 32 + hg], db1 = dtp[(lane + 64) * 64 + 32 + hg];
            const float Af = -__expf(F.alog_f()[hg]) * LOG2E, Ab = -__expf(F.alog_b()[hg]) * LOG2E;
            const float af0 = df0 * Af, af1 = df1 * Af, ab0 = db0 * Ab, ab1 = db1 * Ab;
            const float sf0 = wave_incl_scan(af0, lane), tf0 = __shfl(sf0, 63), sf1 = wave_incl_scan(af1, lane) + tf0;
            const float sb0 = wave_incl_scan(ab0, lane), tb0 = __shfl(sb0, 63), sb1 = wave_incl_scan(ab1, lane) + tb0, totb = __shfl(sb1, 63);
            TAB[lane] = sf0; TAB[64 + lane] = sf1; TAB[128 + lane] = totb - (sb0 - ab0); TAB[192 + lane] = totb - (sb1 - ab1);
            TAB[256 + lane] = df0; TAB[320 + lane] = df1; TAB[384 + lane] = db0; TAB[448 + lane] = db1;
        }
        __syncthreads();
        {
            f32x4 d1[8];
#pragma unroll
            for (int si = 0; si < 8; ++si) d1[si] = (f32x4){0.f, 0.f, 0.f, 0.f};
#pragma unroll 1
            for (int ks = 0; ks < 4; ++ks) {
                const bf16x8 b1 = *(const LAS bf16x8*)(CMi + (16 * w + fr) * 272 + (32 * ks + 8 * fq) * 2);
#pragma unroll
                for (int si = 0; si < 8; ++si) { const bf16x8 a1 = *(const LAS bf16x8*)(BMi + (16 * si + fr) * 272 + (32 * ks + 8 * fq) * 2); d1[si] = MFMA16(a1, b1, d1[si]); }
            }
            __syncthreads();
#pragma unroll
            for (int si = 0; si < 8; ++si) *(LAS v2u*)(BMi + (16 * w + fr) * 272 + (16 * si + 4 * fq) * 2) = (v2u){pk2(d1[si][0], d1[si][1]), pk2(d1[si][2], d1[si][3])};
        }
        __syncthreads();
        const float dsk = F.d_skip()[hg];
#pragma unroll 1
        for (int tg = 0; tg < 4; ++tg) {
            int lane2_ = lane_; asm volatile("" : "+v"(lane2_));
            const int lane = lane2_, fr = lane & 15, fq = lane >> 4;
            const unsigned char* PF = (const unsigned char*)F.ST() + st_off(0, b, c, hg) + (size_t)lane * 16;
            const unsigned char* PB = (const unsigned char*)F.ST() + st_off(1, b, c, hg) + (size_t)lane * 16;
            bf16x8 Gf[2][4];
            {
                const int tA = 16 * (2 * tg) + fr, tB = tA + 16;
                const float cftA = TAB[tA], cbtA = TAB[128 + tA], cftB = TAB[tB], cbtB = TAB[128 + tB];
#pragma unroll
                for (int ks = 0; ks < 4; ++ks) { unsigned pkA[4], pkB[4];
#pragma unroll
                    for (int u = 0; u < 2; ++u) { const int si = 2 * ks + u;
                        const f32x4 cfs = *(const LAS f32x4*)(TAB + 16 * si + 4 * fq), cbs = *(const LAS f32x4*)(TAB + 128 + 16 * si + 4 * fq), dfs = *(const LAS f32x4*)(TAB + 256 + 16 * si + 4 * fq), dbs = *(const LAS f32x4*)(TAB + 384 + 16 * si + 4 * fq);
#pragma unroll
                        for (int tl = 0; tl < 2; ++tl) { const int t = tl ? tB : tA; const float cft = tl ? cftB : cftA, cbt = tl ? cbtB : cbtA; float gv[4];
                            const v2u cbr = *(const LAS v2u*)(BMi + t * 272 + (16 * si + 4 * fq) * 2); const float cbv[4] = {bflo(cbr.x), bfhi(cbr.x), bflo(cbr.y), bfhi(cbr.y)};
                            const int d0 = 16 * (si - 2 * tg - tl) + 4 * fq - fr;
#pragma unroll
                            for (int j = 0; j < 4; ++j) { const int d = d0 + j;
                                const float arg = (d < 0) ? (cft - cfs[j]) : (cbt - cbs[j]), sc = (d < 0) ? dfs[j] : dbs[j];
                                float e = ex2(fminf(arg, 0.f)) * sc; e = (d == 0) ? (dfs[j] + dbs[j]) : e;
                                gv[j] = cbv[j] * e + ((d == 0) ? dsk : 0.f); }
                            if (tl) { pkB[2 * u] = pk2(gv[0], gv[1]); pkB[2 * u + 1] = pk2(gv[2], gv[3]); } else { pkA[2 * u] = pk2(gv[0], gv[1]); pkA[2 * u + 1] = pk2(gv[2], gv[3]); } }
                    }
                    Gf[0][ks] = mk8(pkA[0], pkA[1], pkA[2], pkA[3]); Gf[1][ks] = mk8(pkB[0], pkB[1], pkB[2], pkB[3]);
                    __builtin_amdgcn_sched_barrier(0);
                }
            }
            __builtin_amdgcn_sched_barrier(0);
            f32x4 acc[4][2];
#pragma unroll
            for (int pi = 0; pi < 4; ++pi) { acc[pi][0] = (f32x4){0.f, 0.f, 0.f, 0.f}; acc[pi][1] = (f32x4){0.f, 0.f, 0.f, 0.f}; }
#pragma unroll
            for (int pi = 0; pi < 4; ++pi)
#pragma unroll
                for (int ks = 0; ks < 4; ++ks) { acc[pi][0] = MFMA16(XSf[pi][ks], Gf[0][ks], acc[pi][0]); acc[pi][1] = MFMA16(XSf[pi][ks], Gf[1][ks], acc[pi][1]); }
#pragma unroll
            for (int dir = 0; dir < 2; ++dir) {
                bf16x8 Cs[2][4];
#pragma unroll
                for (int tl = 0; tl < 2; ++tl) {
                    const int t = 16 * (2 * tg + tl) + fr; const float e = ex2(TAB[dir * 128 + t]);
#pragma unroll
                    for (int ks = 0; ks < 4; ++ks) {
                        const LAS unsigned char* cp = CMi + t * 272 + (32 * ks + 4 * fq) * 2; const v2u lo = *(const LAS v2u*)cp, hi = *(const LAS v2u*)(cp + 32);
                        Cs[tl][ks] = mk8(pk2(bflo(lo.x) * e, bfhi(lo.x) * e), pk2(bflo(lo.y) * e, bfhi(lo.y) * e), pk2(bflo(hi.x) * e, bfhi(hi.x) * e), pk2(bflo(hi.y) * e, bfhi(hi.y) * e));
                    }
                }
                const unsigned char* PS = dir ? PB : PF;
                bf16x8 st[4][4];
#pragma unroll
                for (int pi = 0; pi < 4; ++pi)
#pragma unroll
                    for (int ks = 0; ks < 4; ++ks) st[pi][ks] = *(const bf16x8*)(PS + (pi * 4 + ks) * 1024);
#pragma unroll
                for (int pi = 0; pi < 4; ++pi)
#pragma unroll
                    for (int ks = 0; ks < 4; ++ks) { acc[pi][0] = MFMA16(st[pi][ks], Cs[0][ks], acc[pi][0]); acc[pi][1] = MFMA16(st[pi][ks], Cs[1][ks], acc[pi][1]); }
                __builtin_amdgcn_sched_barrier(0);
            }
            float ssq0 = 0.f, ssq1 = 0.f;
#pragma unroll
            for (int pi = 0; pi < 4; ++pi) {
                const int ch = hg * 64 + 16 * pi + 4 * fq;
                {   const size_t token = (size_t)b * SEQ + t0 + 16 * (2 * tg) + fr; const v2u sz = *(const v2u*)(F.SZS() + token * SW + ch);
                    const float h0 = acc[pi][0][0] * bflo(sz.x), h1 = acc[pi][0][1] * bfhi(sz.x), h2 = acc[pi][0][2] * bflo(sz.y), h3 = acc[pi][0][3] * bfhi(sz.y);
                    ssq0 += h0 * h0 + h1 * h1 + h2 * h2 + h3 * h3; *(v2u*)(Y + token * SW + ch) = (v2u){pk2(h0, h1), pk2(h2, h3)}; }
                {   const size_t token = (size_t)b * SEQ + t0 + 16 * (2 * tg + 1) + fr; const v2u sz = *(const v2u*)(F.SZS() + token * SW + ch);
                    const float h0 = acc[pi][1][0] * bflo(sz.x), h1 = acc[pi][1][1] * bfhi(sz.x), h2 = acc[pi][1][2] * bflo(sz.y), h3 = acc[pi][1][3] * bfhi(sz.y);
                    ssq1 += h0 * h0 + h1 * h1 + h2 * h2 + h3 * h3; *(v2u*)(Y + token * SW + ch) = (v2u){pk2(h0, h1), pk2(h2, h3)}; }
            }
            ssq0 += __shfl_xor(ssq0, 16); ssq0 += __shfl_xor(ssq0, 32); ssq1 += __shfl_xor(ssq1, 16); ssq1 += __shfl_xor(ssq1, 32);
            if (fq == 0) { SSQ[w * 128 + 16 * (2 * tg) + fr] = ssq0; SSQ[w * 128 + 16 * (2 * tg + 1) + fr] = ssq1; }
        }
        __syncthreads();
#pragma unroll
        for (int ti = 0; ti < 8; ++ti) {
            const int t = 16 * ti + fr; float tot = 0.f;
#pragma unroll
            for (int ww = 0; ww < 8; ++ww) tot += SSQ[ww * 128 + t];
            const float rs = 1.0f / sqrtf(tot * (1.0f / 512.0f) + LN_EPS);
            const size_t token = (size_t)b * SEQ + t0 + t;
#pragma unroll
            for (int pi = 0; pi < 4; ++pi) { const int ch = hg * 64 + 16 * pi + 4 * fq; const f32x4 nw = *(const f32x4*)(F.norm_w() + ch); bf16* yp = Y + token * SW + ch; const v2u hv = *(const v2u*)yp;
                *(v2u*)yp = (v2u){pk2(bflo(hv.x) * rs * nw[0], bfhi(hv.x) * rs * nw[1]), pk2(bflo(hv.y) * rs * nw[2], bfhi(hv.y) * rs * nw[3])}; }
        }
        __syncthreads();
    }
}

__device__ __forceinline__ void p7_layernorm(Frame& F) {
    const int gw = F.bid * NWAVES + F.wave, NGW = F.G * NWAVES;
    for (int m = gw; m < M; m += NGW) {
        f32x4* xr = (f32x4*)(F.out + (size_t)m * DM) + F.lane;
        f32x4 v[8]; float s = 0.f;
#pragma unroll
        for (int j = 0; j < 8; ++j) { v[j] = xr[64 * j]; s += (v[j][0] + v[j][1]) + (v[j][2] + v[j][3]); }
        const float mean = wave_sum(s) * (1.0f / DM); float s2 = 0.f;
#pragma unroll
        for (int j = 0; j < 8; ++j) { v[j] = v[j] - mean; s2 += (v[j][0] * v[j][0] + v[j][1] * v[j][1]) + (v[j][2] * v[j][2] + v[j][3] * v[j][3]); }
        const float rstd = 1.0f / sqrtf(wave_sum(s2) * (1.0f / DM) + LN_EPS);
#pragma unroll
        for (int j = 0; j < 8; ++j) { const f32x4 gg = *((const f32x4*)F.ln_g() + F.lane + 64 * j), bb = *((const f32x4*)F.ln_b() + F.lane + 64 * j); xr[64 * j] = v[j] * rstd * gg + bb; }
    }
}

struct Args { const float* in[18]; float* out; unsigned char* ws; int ph_lo, ph_hi; };
__global__ void __launch_bounds__(NWAVES * 64, 2) hybrid_fwd(Args args) {
    extern __shared__ __attribute__((aligned(16))) unsigned char lds[];
    Frame F;
    F.lds = (LAS unsigned char*)lds;
    F.MISC = (volatile LAS unsigned*)(F.lds + MISC_OFF);
    F.tid = threadIdx.x; F.lane = F.tid & 63; F.wave = __builtin_amdgcn_readfirstlane(F.tid >> 6);
    F.G = gridDim.x; F.bid = blockIdx.x;
    unsigned char* ws = args.ws;
    F.ctl = (gu32*)(ws + WS_CTL);
    F.in = args.in; F.out = args.out; F.ws = ws;
    for (int u = F.tid; u < 64; u += NWAVES * 64) ((LAS unsigned*)(F.lds + MISC_OFF))[u] = 0u;
    __syncthreads();
    XcdBarrier bar = xcd_barrier_post((unsigned*)(F.ctl + CW_BAR), F.MISC + 8);
    const int lo = args.ph_lo, hi = args.ph_hi;
#ifndef PHASE_MASK
#define PHASE_MASK 0xFF
#endif
#define IN(k) (((PHASE_MASK >> (k)) & 1) && lo <= (k) && (k) < hi)
#define SEAM(k) do { if (IN(k) && IN((k) + 1)) xcd_barrier(bar); } while (0)
    if (IN(0)) { p0_prologue(F); } SEAM(0);
    if (IN(1)) {
        {
        pg8::Gemm gm{F.XB(), F.WIN(), M, N_P1, DM}; pg8::StaticOrder S; S.init(M, N_P1, F.G, F.bid);
        pg8::EpiInProj E{F.YPK(), F.SZF(), F.SZS(), F.XBC()};
        pg8::gemm_phase<pg8::EpiInProj, pg8::StaticOrder, true, true>(F.lds, gm, S, E);
        }
        p1b_dt(F);
    } SEAM(1);
    if (IN(2)) { { p2a_fft1(F); p2b_states(F); } } SEAM(2);
    if (IN(3)) { p3a_fft2(F); p3b_scan(F); } SEAM(3);
    if (IN(4)) { p4_ssd_out(F); } SEAM(4);
    if (IN(5)) {
        {
        bf16* S1 = F.XBC(); bf16* S2 = F.SZS(); bf16* Mb = F.XBC();
        pg8::StaticOrder S; S.init(M, DM, F.G, F.bid);
        { pg8::Gemm gm{F.XB(), F.WIN() + (size_t)COL_GATE * DM, M, DM, DM}; pg8::EpiGate E{S1, DM, F.b_gate()};
          pg8::gemm_phase<pg8::EpiGate, pg8::StaticOrder, true, true>(F.lds, gm, S, E); }
        { pg8::Gemm gm{F.YPK(), F.WBF(), M, DM, FW}; pg8::EpiMul<0> E{S1, nullptr, nullptr, DM};
          pg8::gemm_phase<pg8::EpiMul<0>, pg8::StaticOrder, true, true>(F.lds, gm, S, E); }
        { pg8::Gemm gm{F.XB(), F.WIN() + (size_t)(COL_GATE + DM) * DM, M, DM, DM}; pg8::EpiGate E{S2, DM, F.b_gate() + DM};
          pg8::gemm_phase<pg8::EpiGate, pg8::StaticOrder, true, true>(F.lds, gm, S, E); }
        { pg8::Gemm gm{F.TP(), F.WBS(), M, DM, SW}; pg8::EpiMul<1> E{S1, S2, Mb, DM};
          pg8::gemm_phase<pg8::EpiMul<1>, pg8::StaticOrder, true, true>(F.lds, gm, S, E); }
        }
    } SEAM(5);
    if (IN(6)) {
        {
        pg8::Gemm gm{F.XBC(), F.WOUT(), M, DM, DM}; pg8::StaticOrder S; S.init(M, DM, F.G, F.bid);
        pg8::EpiOut E{F.out, F.x(), DM, DN_ALPHA};
        pg8::gemm_phase<pg8::EpiOut, pg8::StaticOrder, true, true>(F.lds, gm, S, E);
        }
    } SEAM(6);
    if (IN(7)) { p7_layernorm(F); }
#undef IN
#undef SEAM
}

#ifndef MK_CUTS
#define MK_CUTS 0
#endif
extern "C" void kernel_launch(void* const* d_in, const int* in_sizes, int n_in, void* d_out, int out_size, void* d_ws, size_t ws_size, hipStream_t stream) {
    static int grid = 0;
    if (grid == 0) {
        if (n_in != 18 || in_sizes[0] != M * DM || out_size != M * DM || ws_size < WS_END) { fprintf(stderr, "kernel_launch: unexpected shapes (n_in %d, in0 %d, out %d, ws %zu)\n", n_in, n_in > 0 ? in_sizes[0] : -1, out_size, ws_size); grid = -1; return; }
        int dev = 0, cus = 0, per_cu = 0;
        if (hipGetDevice(&dev) != hipSuccess || hipDeviceGetAttribute(&cus, hipDeviceAttributeMultiprocessorCount, dev) != hipSuccess) { grid = -1; return; }
        if (hipFuncSetAttribute((const void*)hybrid_fwd, hipFuncAttributeMaxDynamicSharedMemorySize, LDS_BYTES) != hipSuccess) { fprintf(stderr, "kernel_launch: hipFuncSetAttribute failed\n"); grid = -1; return; }
        if (hipOccupancyMaxActiveBlocksPerMultiprocessor(&per_cu, (const void*)hybrid_fwd, NWAVES * 64, LDS_BYTES) != hipSuccess || per_cu < 1) fprintf(stderr, "kernel_launch: occupancy query reports %d\n", per_cu);
        (void)hipGetLastError();
        grid = cus;
    }
    if (grid < 0) return;
    if (hipMemsetAsync((char*)d_ws + WS_CTL, 0, CTL_ZERO_BYTES, stream) != hipSuccess) { fprintf(stderr, "kernel_launch: memset failed\n"); return; }
    Args a{};
    for (int i = 0; i < 18; ++i) a.in[i] = (const float*)d_in[i];
    a.out = (float*)d_out; a.ws = (unsigned char*)d_ws;
#if MK_CUTS
#ifndef PROBE_DUP
#define PROBE_DUP -1
#endif
    for (int p = 0; p < 8; ++p) { a.ph_lo = p; a.ph_hi = p + 1; hipLaunchKernelGGL(hybrid_fwd, dim3(grid), dim3(NWAVES * 64), LDS_BYTES, stream, a);
        if (p == PROBE_DUP) hipLaunchKernelGGL(hybrid_fwd, dim3(grid), dim3(NWAVES * 64), LDS_BYTES, stream, a); }
#else
    a.ph_lo = 0; a.ph_hi = 8;
    hipLaunchKernelGGL(hybrid_fwd, dim3(grid), dim3(NWAVES * 64), LDS_BYTES, stream, a);
#endif
    const hipError_t le = hipPeekAtLastError();
    if (le != hipSuccess) fprintf(stderr, "kernel_launch: launch failed: %s\n", hipGetErrorName(le));
}
```

```cpp
#include <hip/hip_runtime.h>
#include <cstdio>
#include <cstdint>
namespace pg8 {
#define PG8_LAS __attribute__((address_space(3)))
typedef unsigned short bf16_t;
typedef short bf16x8 __attribute__((ext_vector_type(8)));
typedef float f32x4 __attribute__((ext_vector_type(4)));
typedef unsigned u32x4 __attribute__((ext_vector_type(4)));
constexpr int BM = 256, BK = 64, HALF = 128, HTB = HALF * BK * 2  , STAGE_BYTES = 8 * HTB, NXCD = 8, WGM = 8;

__host__ __device__ __forceinline__ int lds_byte(int r, int c) { const int st = (r >> 4) * 2 + (c >> 5), rr = r & 15, cc = c & 31, ob = rr * 64 + cc * 2; return st * 1024 + (ob ^ (((ob >> 9) & 1) << 5)); }
__host__ __device__ __forceinline__ void stage_rc(int b, int& R, int& C) { const int st = b / 1024, sb = b % 1024, swz = sb ^ (((sb >> 9) & 1) << 5); R = (st >> 1) * 16 + swz / 64; C = (st & 1) * 32 + (swz % 64) / 2; }
__host__ __device__ __forceinline__ int perm32(int rho) { const int n = rho >> 4, i = rho & 15; return 8 * (i >> 2) + 4 * n + (i & 3); }

struct Unit { int pm, pn; };
struct Gemm { const bf16_t* A; const bf16_t* Bt; int M, N, K; };

struct StaticOrder {
    int nM, nN, nwg, G, c;
    __host__ __device__ void init(int M, int N, int G_, int c_) { nM = M / BM; nN = N / BM; nwg = nM * nN; G = G_; c = c_; }
    __host__ __device__ bool next(int i, Unit& u) const {
        const long L = (long)i * G + c; if (L >= nwg) return false;
        int wgid = (int)L; { const int q = nwg / NXCD, r = nwg % NXCD, xcd = wgid % NXCD, off = wgid / NXCD; wgid = (xcd < r ? xcd * (q + 1) : r * (q + 1) + (xcd - r) * q) + off; }
        const int nig = WGM * nN, gid = wgid / nig, fm = gid * WGM, gsz = (nM - fm) < WGM ? (nM - fm) : WGM;
        u.pm = fm + ((wgid % nig) % gsz); u.pn = (wgid % nig) / gsz; return true;
    }
    __device__ __forceinline__ void a_ready(const Unit&) const {}
    __device__ __forceinline__ void done(const Unit&) const {}
};

typedef float cvt_f32x2 __attribute__((ext_vector_type(2))); typedef __bf16 cvt_bf16x2 __attribute__((ext_vector_type(2)));
__device__ __forceinline__ unsigned cvt_pk_bf16(float lo, float hi) { const cvt_f32x2 v = {lo, hi}; const cvt_bf16x2 b = __builtin_convertvector(v, cvt_bf16x2); return __builtin_bit_cast(unsigned, b); }
__device__ __forceinline__ float bflo(unsigned w) { return __builtin_bit_cast(float, w << 16); }
__device__ __forceinline__ float bfhi(unsigned w) { return __builtin_bit_cast(float, w & 0xffff0000u); }
__device__ __forceinline__ float sigm(float v) { return __builtin_amdgcn_rcpf(1.0f + __builtin_amdgcn_exp2f(-1.4426950408889634f * v)); }
__device__ __forceinline__ float silu(float v) { return v * sigm(v); }
__device__ __forceinline__ u32x4 pack8(const f32x4& v0, const f32x4& v1) { u32x4 w; w.x = cvt_pk_bf16(v0[0], v0[1]); w.y = cvt_pk_bf16(v0[2], v0[3]); w.z = cvt_pk_bf16(v1[0], v1[1]); w.w = cvt_pk_bf16(v1[2], v1[3]); return w; }
__device__ __forceinline__ void unpack8(const u32x4& w, f32x4& v0, f32x4& v1) { v0 = (f32x4){bflo(w.x), bfhi(w.x), bflo(w.y), bfhi(w.y)}; v1 = (f32x4){bflo(w.z), bfhi(w.z), bflo(w.w), bfhi(w.w)}; }

struct EpiInProj {
    static constexpr bool PERM = true, AFTER_DRAIN = false;
    bf16_t *ypk, *szf, *szs, *xbc;
    __device__ __forceinline__ void operator()(const f32x4 (&acc)[2][2][4][2], const Unit& u, int wr, int wc, int fr, int fq) const {
        const int pn = u.pn; bf16_t* base; int ldc, colt; bool act;
        if (pn < 4) { base = ypk; ldc = 1024; colt = pn * BM; act = false; }
        else if (pn < 8) { base = szf; ldc = 1024; colt = (pn - 4) * BM; act = true; }
        else if (pn < 16) { base = szs; ldc = 2048; colt = (pn - 8) * BM; act = true; }
        else { base = xbc; ldc = 3072; colt = (pn - 16) * BM; act = false; }
        const int row0 = u.pm * BM + wr * 64 + fr, col0 = colt + wc * 32 + 8 * fq;
#pragma unroll
        for (int ai = 0; ai < 2; ++ai)
#pragma unroll
            for (int m = 0; m < 4; ++m) { bf16_t* rowp = base + (size_t)(row0 + ai * HALF + m * 16) * ldc + col0;
#pragma unroll
                for (int bj = 0; bj < 2; ++bj) { f32x4 v0 = acc[ai][bj][m][0], v1 = acc[ai][bj][m][1];
                    if (act) {
#pragma unroll
                        for (int j = 0; j < 4; ++j) { v0[j] = silu(v0[j]); v1[j] = silu(v1[j]); } }
                    *(u32x4*)(rowp + bj * HALF) = pack8(v0, v1); } }
    }
};
struct EpiGate {
    static constexpr bool PERM = true, AFTER_DRAIN = false;
    bf16_t* S; int ldc; const float* bias;
    __device__ __forceinline__ void operator()(const f32x4 (&acc)[2][2][4][2], const Unit& u, int wr, int wc, int fr, int fq) const {
        const int row0 = u.pm * BM + wr * 64 + fr, col0 = u.pn * BM + wc * 32 + 8 * fq;
        f32x4 bv[2][2];
#pragma unroll
        for (int bj = 0; bj < 2; ++bj)
#pragma unroll
            for (int n = 0; n < 2; ++n) bv[bj][n] = *(const f32x4*)(bias + col0 + bj * HALF + 4 * n);
#pragma unroll
        for (int ai = 0; ai < 2; ++ai)
#pragma unroll
            for (int m = 0; m < 4; ++m) { bf16_t* rowp = S + (size_t)(row0 + ai * HALF + m * 16) * ldc + col0;
#pragma unroll
                for (int bj = 0; bj < 2; ++bj) { f32x4 v0 = acc[ai][bj][m][0] + bv[bj][0], v1 = acc[ai][bj][m][1] + bv[bj][1];
#pragma unroll
                    for (int j = 0; j < 4; ++j) { v0[j] = sigm(v0[j]); v1[j] = sigm(v1[j]); }
                    *(u32x4*)(rowp + bj * HALF) = pack8(v0, v1); } }
    }
};
template <int MODE> struct EpiMul {
    static constexpr bool PERM = true, AFTER_DRAIN = false;
    bf16_t* S1; const bf16_t* S2; bf16_t* O; int ldc;
    __device__ __forceinline__ void operator()(const f32x4 (&acc)[2][2][4][2], const Unit& u, int wr, int wc, int fr, int fq) const {
        const int row0 = u.pm * BM + wr * 64 + fr, col0 = u.pn * BM + wc * 32 + 8 * fq;
#pragma unroll
        for (int ai = 0; ai < 2; ++ai)
#pragma unroll
            for (int m = 0; m < 4; ++m) { const size_t off = (size_t)(row0 + ai * HALF + m * 16) * ldc + col0;
#pragma unroll
                for (int bj = 0; bj < 2; ++bj) {
                    f32x4 a0, a1; unpack8(*(const u32x4*)(S1 + off + bj * HALF), a0, a1);
                    if (MODE == 0) { *(u32x4*)(S1 + off + bj * HALF) = pack8(a0 * acc[ai][bj][m][0], a1 * acc[ai][bj][m][1]); }
                    else { f32x4 g0, g1; unpack8(*(const u32x4*)(S2 + off + bj * HALF), g0, g1);
                           *(u32x4*)(O + off + bj * HALF) = pack8(a0 + g0 * acc[ai][bj][m][0], a1 + g1 * acc[ai][bj][m][1]); } } }
    }
};
struct EpiOut {
    static constexpr bool PERM = false, AFTER_DRAIN = false;
    float* C; const float* X; int ldc; float alpha;
    __device__ __forceinline__ void operator()(const f32x4 (&acc)[2][2][4][2], const Unit& u, int wr, int wc, int fr, int fq) const {
        const int row0 = u.pm * BM + wr * 64 + fr, col0 = u.pn * BM + wc * 32 + 4 * fq;
#pragma unroll
        for (int ai = 0; ai < 2; ++ai)
#pragma unroll
            for (int m = 0; m < 4; ++m) { const size_t off = (size_t)(row0 + ai * HALF + m * 16) * ldc + col0;
#pragma unroll
                for (int bj = 0; bj < 2; ++bj)
#pragma unroll
                    for (int n = 0; n < 2; ++n) { const f32x4 xv = *(const f32x4*)(X + off + bj * HALF + n * 16);
                        *(f32x4*)(C + off + bj * HALF + n * 16) = xv * alpha + acc[ai][bj][m][n]; } }
    }
};
template <class Epi, class Sched, bool ALIGN_EPI = false, bool SP2 = false>
__device__ __forceinline__ void gemm_phase(PG8_LAS unsigned char* lds, const Gemm g, const Sched& S, const Epi& E) {
    const int tid = threadIdx.x, wid = __builtin_amdgcn_readfirstlane(tid >> 6), lane = tid & 63, wr = wid >> 2, wc = wid & 3, fr = lane & 15, fq = lane >> 4;
    const int K = g.K, nt = K / BK;
    unsigned voffA[2], voffB[2];
#pragma unroll
    for (int i = 0; i < 2; ++i) { int R, C; stage_rc(tid * 16 + i * 8192, R, C); const int Rb = Epi::PERM ? ((R & ~31) + perm32(R & 31)) : R;
        voffA[i] = (unsigned)(R * K + C) * 2u; voffB[i] = (unsigned)(Rb * K + C) * 2u; }
    const size_t kstep = (size_t)(BK * 2);
    const size_t hstep = (size_t)HALF * K * 2;
    const size_t tstep = 2 * hstep;
    const unsigned ldsw = (unsigned)wid * 1024u;
    const int aoff = lds_byte(wr * 64 + fr, fq * 8), boff = lds_byte(wc * 32 + fr, fq * 8);
#define PG8_SA(b, h) (((b) * 2 + (h)) * HTB)
#define PG8_SB(b, h) ((4 + (b) * 2 + (h)) * HTB)
#define PG8_STAGE(bufoff, gbase, voff) do { _Pragma("unroll") for (int _i = 0; _i < 2; ++_i) \
        __builtin_amdgcn_global_load_lds((const unsigned*)((const char*)(gbase) + (voff)[_i]), (PG8_LAS unsigned*)(lds + (bufoff) + ldsw + _i * 8192), 16, 0, 0); } while (0)
#define PG8_LDA(dst, b, h) do { _Pragma("unroll") for (int m = 0; m < 4; ++m) _Pragma("unroll") for (int k = 0; k < 2; ++k) dst[m][k] = *(const PG8_LAS bf16x8*)(lds + PG8_SA(b, h) + aoff + m * 2048 + k * 1024); } while (0)
#define PG8_LDB(dst, b, h) do { _Pragma("unroll") for (int n = 0; n < 2; ++n) _Pragma("unroll") for (int k = 0; k < 2; ++k) dst[n][k] = *(const PG8_LAS bf16x8*)(lds + PG8_SB(b, h) + boff + n * 2048 + k * 1024); } while (0)
#define PG8_MMA(ai, bj, At, Bt) do { __builtin_amdgcn_s_setprio(1); _Pragma("unroll") for (int m = 0; m < 4; ++m) _Pragma("unroll") for (int n = 0; n < 2; ++n) _Pragma("unroll") for (int k = 0; k < 2; ++k) \
        acc[ai][bj][m][n] = __builtin_amdgcn_mfma_f32_16x16x32_bf16(Bt[n][k], At[m][k], acc[ai][bj][m][n], 0, 0, 0); __builtin_amdgcn_s_setprio(0); } while (0)
#define PG8_WAIT_V(n) asm volatile("s_waitcnt vmcnt(" #n ")" ::: "memory")
#define PG8_WAIT_L(n) asm volatile("s_waitcnt lgkmcnt(" #n ")" ::: "memory")
#define PG8_BAR __builtin_amdgcn_s_barrier()
#define PG8_SCHED __builtin_amdgcn_sched_barrier(0)
    Unit cur, nxt; int ui = 0;
    if (!S.next(0, cur)) return;
    f32x4 acc[2][2][4][2];
#pragma unroll
    for (int a = 0; a < 2; ++a)
#pragma unroll
        for (int b = 0; b < 2; ++b)
#pragma unroll
            for (int m = 0; m < 4; ++m)
#pragma unroll
                for (int n = 0; n < 2; ++n) acc[a][b][m][n] = (f32x4){0.f, 0.f, 0.f, 0.f};
    bf16x8 At[4][2], B0[2][2], B1[2][2];
    const char* cA = (const char*)g.A + (size_t)cur.pm * tstep; const char* cB = (const char*)g.Bt + (size_t)cur.pn * tstep;
    S.a_ready(cur);
    if constexpr (SP2) {
        PG8_STAGE(PG8_SB(0, 0), cB, voffB); PG8_STAGE(PG8_SB(0, 1), cB + hstep, voffB); PG8_STAGE(PG8_SA(0, 0), cA, voffA); PG8_STAGE(PG8_SA(0, 1), cA + hstep, voffA);
        if (wr == 1) PG8_BAR;
        PG8_WAIT_V(2); PG8_BAR;
        PG8_STAGE(PG8_SB(1, 0), cB + kstep, voffB); PG8_STAGE(PG8_SA(1, 0), cA + kstep, voffA); PG8_STAGE(PG8_SB(1, 1), cB + hstep + kstep, voffB);
        PG8_WAIT_V(6); PG8_BAR;
    } else {
        PG8_STAGE(PG8_SB(0, 0), cB, voffB); PG8_STAGE(PG8_SA(0, 0), cA, voffA); PG8_STAGE(PG8_SB(0, 1), cB + hstep, voffB); PG8_STAGE(PG8_SA(0, 1), cA + hstep, voffA);
        if (wr == 1) PG8_BAR;
        PG8_WAIT_V(4); PG8_BAR;
        PG8_STAGE(PG8_SB(1, 0), cB + kstep, voffB); PG8_STAGE(PG8_SA(1, 0), cA + kstep, voffA); PG8_STAGE(PG8_SB(1, 1), cB + hstep + kstep, voffB);
        PG8_WAIT_V(6); PG8_BAR;
    }
    for (;;) {
        const bool has_next = S.next(ui + 1, nxt);
        const char* nA = has_next ? (const char*)g.A + (size_t)nxt.pm * tstep : cA; const char* nB = has_next ? (const char*)g.Bt + (size_t)nxt.pn * tstep : cB;
        for (int t = 0; t < nt; t += 2) {
            const bool last = (t == nt - 2);
            const char* a1 = cA + (size_t)(t + 1) * kstep;
            const char* a2 = last ? nA : cA + (size_t)(t + 2) * kstep; const char* b2 = last ? nB : cB + (size_t)(t + 2) * kstep;
            const char* a3 = a2 + kstep; const char* b3 = b2 + kstep;
            if (last && has_next) S.a_ready(nxt);
            if constexpr (SP2) {
            PG8_LDB(B0, 0, 0); PG8_LDB(B1, 0, 1); PG8_SCHED; PG8_LDA(At, 0, 0); PG8_STAGE(PG8_SA(1, 1), a1 + hstep, voffA);
            PG8_WAIT_V(8); PG8_WAIT_L(0); PG8_BAR; PG8_MMA(0, 0, At, B0); PG8_MMA(0, 1, At, B1); PG8_BAR; PG8_SCHED;
            PG8_LDA(At, 0, 1); PG8_STAGE(PG8_SB(0, 0), b2, voffB); PG8_STAGE(PG8_SB(0, 1), b2 + hstep, voffB); PG8_STAGE(PG8_SA(0, 0), a2, voffA);
            PG8_WAIT_V(8); PG8_WAIT_L(0); PG8_BAR; PG8_MMA(1, 0, At, B0); PG8_MMA(1, 1, At, B1); PG8_BAR; PG8_SCHED;
            PG8_LDB(B0, 1, 0); PG8_LDB(B1, 1, 1); PG8_SCHED; PG8_LDA(At, 1, 0); PG8_STAGE(PG8_SA(0, 1), a2 + hstep, voffA);
            PG8_WAIT_V(8); PG8_WAIT_L(0); PG8_BAR; PG8_MMA(0, 0, At, B0); PG8_MMA(0, 1, At, B1); PG8_BAR; PG8_SCHED;
            PG8_LDA(At, 1, 1); PG8_STAGE(PG8_SB(1, 0), b3, voffB); PG8_STAGE(PG8_SB(1, 1), b3 + hstep, voffB); PG8_STAGE(PG8_SA(1, 0), a3, voffA);
            PG8_WAIT_V(8); PG8_WAIT_L(0); PG8_BAR; PG8_MMA(1, 0, At, B0); PG8_MMA(1, 1, At, B1); PG8_BAR; PG8_SCHED;
            } else {
            PG8_LDB(B0, 0, 0); PG8_SCHED; PG8_LDA(At, 0, 0); PG8_STAGE(PG8_SA(1, 1), a1 + hstep, voffA);
            PG8_WAIT_L(8); PG8_BAR; PG8_WAIT_L(0); PG8_MMA(0, 0, At, B0); PG8_BAR; PG8_SCHED;
            PG8_LDB(B1, 0, 1); PG8_STAGE(PG8_SB(0, 0), b2, voffB);
            PG8_BAR; PG8_WAIT_L(0); PG8_MMA(0, 1, At, B1); PG8_BAR;
            PG8_LDA(At, 0, 1); PG8_STAGE(PG8_SA(0, 0), a2, voffA);
            PG8_BAR; PG8_WAIT_L(0); PG8_MMA(1, 0, At, B0); PG8_BAR; PG8_SCHED;
            PG8_STAGE(PG8_SB(0, 1), b2 + hstep, voffB);
            PG8_WAIT_V(6); PG8_BAR; PG8_MMA(1, 1, At, B1); PG8_BAR;
            PG8_LDB(B0, 1, 0); PG8_SCHED; PG8_LDA(At, 1, 0); PG8_STAGE(PG8_SA(0, 1), a2 + hstep, voffA);
            PG8_WAIT_L(8); PG8_BAR; PG8_WAIT_L(0); PG8_MMA(0, 0, At, B0); PG8_BAR; PG8_SCHED;
            PG8_LDB(B1, 1, 1); PG8_STAGE(PG8_SB(1, 0), b3, voffB);
            PG8_BAR; PG8_WAIT_L(0); PG8_MMA(0, 1, At, B1); PG8_BAR;
            PG8_LDA(At, 1, 1); PG8_STAGE(PG8_SA(1, 0), a3, voffA);
            PG8_BAR; PG8_WAIT_L(0); PG8_MMA(1, 0, At, B0); PG8_BAR; PG8_SCHED;
            PG8_STAGE(PG8_SB(1, 1), b3 + hstep, voffB);
            PG8_WAIT_V(6); PG8_BAR; PG8_MMA(1, 1, At, B1); PG8_BAR;
            }
        }
        if constexpr (ALIGN_EPI) { if (wr == 0) PG8_BAR; }
        if constexpr (!Epi::AFTER_DRAIN) { E(acc, cur, wr, wc, fr, fq); S.done(cur); }
        if (!has_next) break;
#pragma unroll
        for (int a = 0; a < 2; ++a)
#pragma unroll
            for (int b = 0; b < 2; ++b)
#pragma unroll
                for (int m = 0; m < 4; ++m)
#pragma unroll
                    for (int n = 0; n < 2; ++n) acc[a][b][m][n] = (f32x4){0.f, 0.f, 0.f, 0.f};
        cur = nxt; cA = nA; cB = nB; ++ui;
        if constexpr (ALIGN_EPI) { if (wr == 1) PG8_BAR; }
    }
    PG8_WAIT_V(0);
    if constexpr (!ALIGN_EPI) { if (wr == 0) PG8_BAR; }
    PG8_BAR;
    if constexpr (Epi::AFTER_DRAIN) { E.fused(acc, cur, wr, wc, fr, fq, lds, wid, lane); S.done(cur); }
#undef PG8_SA
#undef PG8_SB
#undef PG8_STAGE
#undef PG8_LDA
#undef PG8_LDB
#undef PG8_MMA
#undef PG8_WAIT_V
#undef PG8_WAIT_L
#undef PG8_BAR
#undef PG8_SCHED
}
}
#define GAS __attribute__((address_space(1)))
#define LAS __attribute__((address_space(3)))
typedef unsigned short bf16;
typedef unsigned v4u __attribute__((ext_vector_type(4)));
typedef float f32x4 __attribute__((ext_vector_type(4)));
typedef short bf16x8 __attribute__((ext_vector_type(8)));
typedef GAS unsigned gu32;
typedef GAS unsigned long long gu64;
#define RLX_AGENT __ATOMIC_RELAXED, __HIP_MEMORY_SCOPE_AGENT
#define LDS_WAIT() asm volatile("s_waitcnt lgkmcnt(0)" ::: "memory")
#define VM_WAIT() asm volatile("s_waitcnt vmcnt(0)" ::: "memory")
__device__ __forceinline__ unsigned long long rt() { return __builtin_amdgcn_s_memrealtime(); }

#define XB_TMO      128
#define XB_XCNT(j)  (256  + 64 * (j))
#define XB_XSUB(j)  (1280 + 64 * (j))
#define XB_XGEN(j)  (2304 + 64 * (j))
#define XB_TOP      3328
#define XB_TOPGEN   3392
#define XCD_BAR_WORDS 3456
#define XB_SPIN_CAP (1u << 18)

__device__ __forceinline__ unsigned xb_ld(unsigned* p)              { return __hip_atomic_load(p, __ATOMIC_RELAXED, __HIP_MEMORY_SCOPE_AGENT); }
__device__ __forceinline__ unsigned xb_add(unsigned* p, unsigned v) { return __hip_atomic_fetch_add(p, v, __ATOMIC_RELAXED, __HIP_MEMORY_SCOPE_AGENT); }
__device__ __forceinline__ unsigned xb_xcc_id() { return (unsigned)__builtin_amdgcn_s_getreg((3 << 11) | 20) & 0xFu; }
#define XB_SPIN(cond, bar) do { unsigned _sp = 0; while (cond) { __builtin_amdgcn_s_sleep(1); \
    if ((++_sp & 255u) == 0u) { if (xb_ld(&(bar)[XB_TMO])) break; if (_sp > XB_SPIN_CAP) { atomicAdd(&(bar)[XB_TMO], 1u); break; } } } } while (0)

struct XcdBarrier {
    unsigned* bar; unsigned x;
    volatile LAS unsigned* st;
};

__device__ __forceinline__ XcdBarrier xcd_barrier_post(unsigned* bar, volatile LAS unsigned* st) {
    XcdBarrier b; b.bar = bar; b.x = xb_xcc_id(); b.st = st;
    if (threadIdx.x == 0) (void)xb_add(&bar[XB_XCNT(b.x)], 1u);
    return b;
}
__device__ __forceinline__ void xcd_barrier_complete(unsigned* bar, unsigned x, unsigned& nloc, unsigned& nx) {
    const unsigned G = gridDim.x * gridDim.y * gridDim.z;
    unsigned sum, cnt, mine, sp = 0u;
    for (;;) {
        sum = 0u; cnt = 0u; mine = 0u;
#pragma unroll
        for (unsigned j = 0; j < 16; ++j) { const unsigned c = xb_ld(&bar[XB_XCNT(j)]); sum += c; cnt += (c > 0u) ? 1u : 0u; mine = (j == x) ? c : mine; }
        if (sum == G) break;
        __builtin_amdgcn_s_sleep(1);
        if ((++sp & 255u) == 0u) { if (xb_ld(&bar[XB_TMO])) break; if (sp > XB_SPIN_CAP) { atomicAdd(&bar[XB_TMO], 1u); break; } }
    }
    nloc = mine > 0u ? mine : 1u; nx = cnt > 0u ? cnt : 1u;
}

__device__ __forceinline__ void xcd_barrier(const XcdBarrier& b) {
    asm volatile("s_waitcnt vmcnt(0)" ::: "memory");
    __syncthreads();
    if (threadIdx.x == 0) {
        unsigned* bar = b.bar;
        __builtin_amdgcn_s_waitcnt(0);
        unsigned nloc = b.st[0], nx = b.st[1];
        if (nloc == 0u) { xcd_barrier_complete(bar, b.x, nloc, nx); b.st[0] = nloc; b.st[1] = nx; }
        const unsigned old = xb_add(&bar[XB_XSUB(b.x)], 1u);
        const unsigned gen = old / nloc;
        if (old + 1u == (gen + 1u) * nloc) {
            __builtin_amdgcn_fence(__ATOMIC_RELEASE, "agent");
            asm volatile("s_waitcnt vmcnt(0)" ::: "memory");
            const unsigned og = xb_add(&bar[XB_TOP], 1u);
            const unsigned tg = og / nx;
            if (og + 1u == (tg + 1u) * nx) xb_add(&bar[XB_TOPGEN], 1u);
            else XB_SPIN(xb_ld(&bar[XB_TOPGEN]) == tg, bar);
            __builtin_amdgcn_fence(__ATOMIC_ACQUIRE, "agent");
            xb_add(&bar[XB_XGEN(b.x)], 1u);
            asm volatile("s_waitcnt vmcnt(0)" ::: "memory");
        } else {
            XB_SPIN(xb_ld(&bar[XB_XGEN(b.x)]) == gen, bar);
            __builtin_amdgcn_fence(__ATOMIC_ACQUIRE, "agent");
            asm volatile("s_waitcnt vmcnt(0)" ::: "memory");
        }
    }
    __syncthreads();
}
constexpr int NWAVES = 8;
constexpr int BATCH = 2, SEQ = 8192, DM = 2048, M = BATCH * SEQ;
constexpr int FW = 1024, SW = 2048, NHEAD = 32, CONVCH = 3072, CHUNK = 128, NCHUNK = SEQ / CHUNK;
constexpr int N_IN = 11328, N_P1 = 7168;
constexpr int COL_DT = 7168, COL_GATE = 7232;
constexpr float LN_EPS = 1e-5f, LOG2E = 1.4426950408889634f;
constexpr float DN_ALPHA = 1.189207115002721f;

constexpr size_t MiB = 1u << 20;
constexpr size_t WS_CTL = 0, CTL_ZERO_BYTES = 1 * MiB;
constexpr size_t WS_TW = 1 * MiB;
constexpr size_t WS_F1C = WS_TW + 65536;
constexpr size_t WS_F1S = WS_F1C + 8192;
constexpr size_t WS_W3 = WS_F1S + 8192;
constexpr size_t WS_DEC = WS_W3 + 65536;
constexpr size_t WS_WMIX = WS_DEC + 32768;
constexpr size_t WS_WIN = 2 * MiB;
constexpr size_t WS_WBF = 47 * MiB;
constexpr size_t WS_WBS = 51 * MiB;
constexpr size_t WS_WOUT = 59 * MiB;
constexpr size_t WS_XB = 68 * MiB;
constexpr size_t WS_YPK = 132 * MiB;
constexpr size_t WS_SZF = 164 * MiB;
constexpr size_t WS_SZS = 196 * MiB;
constexpr size_t WS_XBC = 260 * MiB;
constexpr size_t WS_DT = 356 * MiB;
constexpr size_t WS_TP = 360 * MiB;
constexpr size_t WS_XSF = 424 * MiB;
constexpr size_t WS_END = 488 * MiB;
static_assert(WS_WMIX + 262144 <= WS_WIN && WS_WIN + (size_t)N_IN * DM * 2 <= WS_WBF, "ws map");
constexpr int CW_BAR = 4096;

constexpr int LDS_BYTES = 163840;
constexpr int MISC_OFF = LDS_BYTES - 256;

typedef short s16x4 __attribute__((ext_vector_type(4)));
typedef unsigned v2u __attribute__((ext_vector_type(2)));
typedef float f32x2 __attribute__((ext_vector_type(2)));
#define MFMA16(a, b, c) __builtin_amdgcn_mfma_f32_16x16x32_bf16((a), (b), (c), 0, 0, 0)
__device__ __forceinline__ unsigned pk2(float lo, float hi) { return pg8::cvt_pk_bf16(lo, hi); }
__device__ __forceinline__ float bflo(unsigned w) { return __builtin_bit_cast(float, w << 16); }
__device__ __forceinline__ float bfhi(unsigned w) { return __builtin_bit_cast(float, w & 0xffff0000u); }
__device__ __forceinline__ float ex2(float v) { return __builtin_amdgcn_exp2f(v); }
__device__ __forceinline__ s16x4 trread(const LAS unsigned char* p) { return __builtin_bit_cast(s16x4, __builtin_amdgcn_ds_read_tr16_b64_v4i16((LAS s16x4*)p)); }
__device__ __forceinline__ bf16x8 frag_tr(const LAS unsigned char* img, int rs, int klo, int khi, int c0, int fr) {
    const int off = (fr >> 2) * rs + (c0 + 4 * (fr & 3)) * 2;
    const s16x4 lo = trread(img + klo * rs + off), hi = trread(img + khi * rs + off);
    return (bf16x8){lo[0], lo[1], lo[2], lo[3], hi[0], hi[1], hi[2], hi[3]};
}
__device__ __forceinline__ bf16x8 mk8(unsigned a, unsigned b, unsigned c, unsigned d) { return __builtin_bit_cast(bf16x8, (v4u){a, b, c, d}); }
__device__ __forceinline__ float wave_sum(float v) {
#pragma unroll
    for (int o = 1; o < 64; o <<= 1) v += __shfl_xor(v, o);
    return v;
}
__device__ __forceinline__ float wave_incl_scan(float v, int lane) {
#pragma unroll
    for (int o = 1; o < 64; o <<= 1) { const float t = __shfl_up(v, o); if (lane >= o) v += t; }
    return v;
}

struct Frame {
    LAS unsigned char* lds;
    volatile LAS unsigned* MISC;
    gu32* ctl;
    int tid, lane, wave, bid, G, variant;
    const float* const* in;
    float* out; unsigned char* ws;
    __device__ __forceinline__ const float* x() const { return in[0]; }
    __device__ __forceinline__ const float* w_in() const { return in[1]; }
    __device__ __forceinline__ const float* b_gate() const { return in[2]; }
    __device__ __forceinline__ const float* conv_w() const { return in[3]; }
    __device__ __forceinline__ const float* conv_b() const { return in[4]; }
    __device__ __forceinline__ const float* dtb_f() const { return in[5]; }
    __device__ __forceinline__ const float* alog_f() const { return in[6]; }
    __device__ __forceinline__ const float* dtb_b() const { return in[7]; }
    __device__ __forceinline__ const float* alog_b() const { return in[8]; }
    __device__ __forceinline__ const float* d_skip() const { return in[9]; }
    __device__ __forceinline__ const float* norm_w() const { return in[10]; }
    __device__ __forceinline__ const float* fmix_w() const { return in[11]; }
    __device__ __forceinline__ const float* fmix_b() const { return in[12]; }
    __device__ __forceinline__ const float* w_bf() const { return in[13]; }
    __device__ __forceinline__ const float* w_bs() const { return in[14]; }
    __device__ __forceinline__ const float* w_out() const { return in[15]; }
    __device__ __forceinline__ const float* ln_g() const { return in[16]; }
    __device__ __forceinline__ const float* ln_b() const { return in[17]; }
    __device__ __forceinline__ float2* TW() const { return (float2*)(ws + WS_TW); }
    __device__ __forceinline__ bf16* F1C() const { return (bf16*)(ws + WS_F1C); }
    __device__ __forceinline__ bf16* F1S() const { return (bf16*)(ws + WS_F1S); }
    __device__ __forceinline__ bf16* W3() const { return (bf16*)(ws + WS_W3); }
    __device__ __forceinline__ bf16* WMIX() const { return (bf16*)(ws + WS_WMIX); }
    __device__ __forceinline__ float* DEC() const { return (float*)(ws + WS_DEC); }
    __device__ __forceinline__ bf16* WIN() const { return (bf16*)(ws + WS_WIN); }
    __device__ __forceinline__ bf16* WBF() const { return (bf16*)(ws + WS_WBF); }
    __device__ __forceinline__ bf16* WBS() const { return (bf16*)(ws + WS_WBS); }
    __device__ __forceinline__ bf16* WOUT() const { return (bf16*)(ws + WS_WOUT); }
    __device__ __forceinline__ bf16* XB() const { return (bf16*)(ws + WS_XB); }
    __device__ __forceinline__ bf16* YPK() const { return (bf16*)(ws + WS_YPK); }
    __device__ __forceinline__ bf16* SZF() const { return (bf16*)(ws + WS_SZF); }
    __device__ __forceinline__ bf16* SZS() const { return (bf16*)(ws + WS_SZS); }
    __device__ __forceinline__ bf16* XBC() const { return (bf16*)(ws + WS_XBC); }
    __device__ __forceinline__ bf16* TP() const { return (bf16*)(ws + WS_TP); }
    __device__ __forceinline__ float* DT() const { return (float*)(ws + WS_DT); }
    __device__ __forceinline__ unsigned char* XSF() const { return ws + WS_XSF; }
    __device__ __forceinline__ bf16* ST() const { return (bf16*)out; }
};

__device__ __forceinline__ void p0_transpose_item(const float* W, int K, int N, bf16* WT, LAS float* scr, int kb, int nb, int lane) {
    const int k0 = 64 * kb, n0 = 32 * nb;
#pragma unroll 8
    for (int i = 0; i < 32; ++i) { const int kk = 2 * i + (lane >> 5); scr[kk * 33 + (lane & 31)] = W[(size_t)(k0 + kk) * N + n0 + (lane & 31)]; }
    LDS_WAIT(); asm volatile("" ::: "memory");
    const int c = lane & 7;
#pragma unroll
    for (int j = 0; j < 4; ++j) { const int n = (lane >> 3) + 8 * j; const LAS float* s = scr + (8 * c) * 33 + n;
        v4u o; o.x = pk2(s[0 * 33], s[1 * 33]); o.y = pk2(s[2 * 33], s[3 * 33]); o.z = pk2(s[4 * 33], s[5 * 33]); o.w = pk2(s[6 * 33], s[7 * 33]);
        *(v4u*)(WT + (size_t)(n0 + n) * K + k0 + 8 * c) = o; }
    LDS_WAIT(); asm volatile("" ::: "memory");
}
__device__ __forceinline__ void p0_prologue(Frame& F) {
    const int gw = F.bid * NWAVES + F.wave, NGW = F.G * NWAVES, gt = F.bid * 512 + F.tid, NGT = F.G * 512;
    for (int u = gt; u < M * DM / 8; u += NGT) { const f32x4 a = *(const f32x4*)(F.x() + (size_t)u * 8), b = *(const f32x4*)(F.x() + (size_t)u * 8 + 4);
        *(v4u*)(F.XB() + (size_t)u * 8) = (v4u){pk2(a[0], a[1]), pk2(a[2], a[3]), pk2(b[0], b[1]), pk2(b[2], b[3])}; }
    for (int i = gt; i < 8192; i += NGT) { float s, c; sincospif((float)i * (1.0f / 4096.0f), &s, &c); F.TW()[i] = make_float2(c, s); }
    for (int i = gt; i < 4096; i += NGT) { const int ka = i >> 6, na = i & 63; float s, c; sincospif((float)((ka * na) & 63) * (1.0f / 32.0f), &s, &c);
        F.F1C()[i] = (bf16)(pk2(c, 0.f) & 0xffffu); F.F1S()[i] = (bf16)(pk2(-s, 0.f) & 0xffffu); }
    for (int i = gt; i < 128 * 256; i += NGT) { const int kb = i >> 8, k = i & 255, nb = k >> 1, ri = k & 1; float s, c; sincospif((float)((kb * nb) & 127) * (1.0f / 64.0f), &s, &c);
        F.W3()[i] = (bf16)(pk2(ri ? s : c, 0.f) & 0xffffu); }
    for (int i = gt; i < 8 * 128 * 128; i += NGT) { const int c = i & 127, o = (i >> 7) & 127, g = i >> 14; const float* Wg = F.fmix_w() + (size_t)g * 16384;
        float v;
        if (c <= 64) { v = Wg[c * 128 + o]; if (c >= 1 && c <= 63) v += Wg[(128 - c) * 128 + o]; }
        else { const int k2 = c - 64; v = Wg[k2 * 128 + o] - Wg[(128 - k2) * 128 + o]; }
        F.WMIX()[i] = (bf16)(pk2(v, 0.f) & 0xffffu); }
    {
        LAS float* scr = (LAS float*)(F.lds + 65536 + F.wave * 8704);
        constexpr int NB_IN = (N_IN - 1024) / 32;
        constexpr int I_IN = 32 * NB_IN, I_BF = 16 * 64, I_BS = 32 * 64, I_OUT = 32 * 64;
        for (int it = gw; it < I_IN + I_BF + I_BS + I_OUT; it += NGW) {
            int r = it;
            if (r < I_IN) { p0_transpose_item(F.w_in(), DM, N_IN, F.WIN(), scr, r / NB_IN, 32 + r % NB_IN, F.lane); continue; } r -= I_IN;
            if (r < I_BF) { p0_transpose_item(F.w_bf(), FW, DM, F.WBF(), scr, r / 64, r % 64, F.lane); continue; } r -= I_BF;
            if (r < I_BS) { p0_transpose_item(F.w_bs(), SW, DM, F.WBS(), scr, r / 64, r % 64, F.lane); continue; } r -= I_BS;
            p0_transpose_item(F.w_out(), DM, DM, F.WOUT(), scr, r / 64, r % 64, F.lane);
        }
    }
    __syncthreads();
    {
        LAS float* tile = (LAS float*)F.lds;
        LAS float* ctab = (LAS float*)(F.lds + 33024);
        LAS float* stab = ctab + 128;
        LAS unsigned short* otile = (LAS unsigned short*)(F.lds + 34048);
        if (F.tid < 128) { float s, c; sincospif((float)F.tid * (1.0f / 64.0f), &s, &c); ctab[F.tid] = c * (1.0f / 1024.0f); stab[F.tid] = -s * (1.0f / 1024.0f); }
        for (int it = F.bid; it < 8 * 32; it += F.G) {
            const int g = it >> 5, k0 = (it & 31) * 64;
            __syncthreads();
            for (int i = F.tid; i < 64 * 128; i += 512) { const int kk = i >> 7, n2 = i & 127; tile[kk * 129 + n2] = F.w_in()[(size_t)(k0 + kk) * N_IN + g * 128 + n2]; }
            __syncthreads();
            const int kk = F.tid & 63;
            for (int ci = 0; ci < 16; ++ci) { const int c = (F.tid >> 6) + 8 * ci; const int cc = (c <= 64) ? c : c - 64; const LAS float* tab = (c <= 64) ? ctab : stab;
                float acc = 0.f;
#pragma unroll 8
                for (int n2 = 0; n2 < 128; ++n2) acc += tile[kk * 129 + n2] * tab[(n2 * cc) & 127];
                otile[c * 72 + kk] = (unsigned short)(pk2(acc, 0.f) & 0xffffu); }
            __syncthreads();
            for (int i = F.tid; i < 128 * 8; i += 512) { const int c = i >> 3, pc = i & 7;
                *(v4u*)(F.WIN() + (size_t)(g * 128 + c) * DM + k0 + pc * 8) = *(const LAS v4u*)(otile + c * 72 + pc * 8); }
        }
        __syncthreads();
    }
}

__device__ __forceinline__ float softplus(float v) { return fmaxf(v, 0.f) + log1pf(__expf(-fabsf(v))); }
__device__ __forceinline__ void p1b_dt(Frame& F) {
    const int fr = F.lane & 15, fq = F.lane >> 4, mt = F.wave >> 1, nt0 = 2 * (F.wave & 1);
    const bf16* WDT = F.WIN() + (size_t)COL_DT * DM;
    for (int rb = F.bid; rb < M / 64; rb += F.G) {
        const int r0 = rb * 64;
        f32x4 acc[2] = {{0.f, 0.f, 0.f, 0.f}, {0.f, 0.f, 0.f, 0.f}};
        const bf16* ap = F.XB() + (size_t)(r0 + 16 * mt + fr) * DM + 8 * fq;
        const bf16* bp0 = WDT + (size_t)(16 * nt0 + fr) * DM + 8 * fq;
        const bf16* bp1 = bp0 + (size_t)16 * DM;
#pragma unroll 8
        for (int ks = 0; ks < DM / 32; ++ks) { const bf16x8 a = *(const bf16x8*)(ap + 32 * ks), b0 = *(const bf16x8*)(bp0 + 32 * ks), b1 = *(const bf16x8*)(bp1 + 32 * ks);
            acc[0] = MFMA16(a, b0, acc[0]); acc[1] = MFMA16(a, b1, acc[1]); }
#pragma unroll
        for (int u = 0; u < 2; ++u) { const int n = 16 * (nt0 + u) + fr; const float bias = (n < 32) ? F.dtb_f()[n] : F.dtb_b()[n - 32];
#pragma unroll
            for (int j = 0; j < 4; ++j) F.DT()[(size_t)(r0 + 16 * mt + 4 * fq + j) * 64 + n] = softplus(acc[u][j] + bias); }
    }
}

__device__ __forceinline__ void p2a_fft1(Frame& F) {
    const int fr = F.lane & 15, fq = F.lane >> 4, w = F.wave;
    LAS unsigned char* YS = F.lds;
    LAS unsigned char* OUT = F.lds + 34816;
    bf16x8 fc[4][2], fs[4][2];
#pragma unroll
    for (int ni = 0; ni < 4; ++ni)
#pragma unroll
        for (int ks = 0; ks < 2; ++ks) { fc[ni][ks] = *(const bf16x8*)(F.F1C() + (16 * ni + fr) * 64 + 32 * ks + 8 * fq); fs[ni][ks] = *(const bf16x8*)(F.F1S() + (16 * ni + fr) * 64 + 32 * ks + 8 * fq); }
    for (int item = F.bid; item < 256; item += F.G) {
        const int b = item >> 7, nb = item & 127;
        float twc[4], tws[4];
#pragma unroll
        for (int ni = 0; ni < 4; ++ni) { const float2 t = F.TW()[(nb * (16 * ni + fr)) & 8191]; twc[ni] = t.x; tws[ni] = t.y; }
        for (int ch = 0; ch < 4; ++ch) {
#pragma unroll
            for (int i = 0; i < 4; ++i) { const int id = F.tid + 512 * i, row = id >> 5, pc = id & 31;
                *(LAS v4u*)(YS + row * 544 + pc * 16) = *(const v4u*)(F.YPK() + (size_t)(b * SEQ + 128 * row + nb) * FW + ch * 256 + pc * 8); }
            __syncthreads();
            f32x4 ar[2][4], ai[2][4];
#pragma unroll
            for (int mi = 0; mi < 2; ++mi)
#pragma unroll
                for (int ni = 0; ni < 4; ++ni) { ar[mi][ni] = (f32x4){0.f, 0.f, 0.f, 0.f}; ai[mi][ni] = (f32x4){0.f, 0.f, 0.f, 0.f}; }
#pragma unroll
            for (int ks = 0; ks < 2; ++ks)
#pragma unroll
                for (int mi = 0; mi < 2; ++mi) { const bf16x8 a = frag_tr(YS, 544, 32 * ks + 8 * fq, 32 * ks + 8 * fq + 4, 32 * w + 16 * mi, fr);
#pragma unroll
                    for (int ni = 0; ni < 4; ++ni) { ar[mi][ni] = MFMA16(a, fc[ni][ks], ar[mi][ni]); ai[mi][ni] = MFMA16(a, fs[ni][ks], ai[mi][ni]); } }
#pragma unroll
            for (int mi = 0; mi < 2; ++mi) { const int cl = 32 * w + 16 * mi + 4 * fq, gl = cl >> 7, cc = cl & 127;
#pragma unroll
                for (int ni = 0; ni < 4; ++ni) { const int ka = 16 * ni + fr; float r2[4], i2[4];
#pragma unroll
                    for (int j = 0; j < 4; ++j) { const float tr = ar[mi][ni][j], ti = ai[mi][ni][j]; float a = tr * twc[ni] + ti * tws[ni], bb = ti * twc[ni] - tr * tws[ni];
                        if (cc + j >= 65) { const float t = a; a = -bb; bb = t; }
                        r2[j] = a; i2[j] = bb; }
                    LAS unsigned char* o = OUT + ((ka * 2 + gl) * 2) * 256 + cc * 2;
                    *(LAS v2u*)o = (v2u){pk2(r2[0], r2[1]), pk2(r2[2], r2[3])};
                    *(LAS v2u*)(o + 256) = (v2u){pk2(i2[0], i2[1]), pk2(i2[2], i2[3])}; } }
            __syncthreads();
#pragma unroll
            for (int i = 0; i < 8; ++i) { const int id = F.tid + 512 * i, piece = id >> 4, off = (id & 15) * 16, ka = piece >> 2, gl = (piece >> 1) & 1, ri = piece & 1, g = ch * 2 + gl;
                *(v4u*)((unsigned char*)F.TP() + (((((size_t)(b * 64 + ka) * 8 + g) * 128 + nb) * 2 + ri) * 128) * 2 + off) = *(const LAS v4u*)(OUT + piece * 256 + off); }
            __syncthreads();
        }
    }
}

struct ConvW { float w[5][8]; float b[8]; };
__device__ __forceinline__ void conv_load_w(ConvW& cw, const float* conv_w, const float* conv_b, int col0) {
#pragma unroll
    for (int t = 0; t < 5; ++t) { const f32x4 a = *(const f32x4*)(conv_w + t * CONVCH + col0), b = *(const f32x4*)(conv_w + t * CONVCH + col0 + 4);
#pragma unroll
        for (int j = 0; j < 4; ++j) { cw.w[t][j] = a[j]; cw.w[t][4 + j] = b[j]; } }
    const f32x4 a = *(const f32x4*)(conv_b + col0), b = *(const f32x4*)(conv_b + col0 + 4);
#pragma unroll
    for (int j = 0; j < 4; ++j) { cw.b[j] = a[j]; cw.b[4 + j] = b[j]; }
}
__device__ __forceinline__ v4u conv8(const bf16* xb_, int t, int col0, const ConvW& cw) {
    float o[8];
#pragma unroll
    for (int j = 0; j < 8; ++j) o[j] = cw.b[j];
#pragma unroll
    for (int tap = 0; tap < 5; ++tap) { const int tt = t + tap - 2; const bool ok = (tt >= 0) && (tt < SEQ); const int tc = ok ? tt : t;
        const v4u r = *(const v4u*)(xb_ + (size_t)tc * CONVCH + col0); const float m = ok ? 1.f : 0.f;
        o[0] += cw.w[tap][0] * (m * bflo(r.x)); o[1] += cw.w[tap][1] * (m * bfhi(r.x)); o[2] += cw.w[tap][2] * (m * bflo(r.y)); o[3] += cw.w[tap][3] * (m * bfhi(r.y));
        o[4] += cw.w[tap][4] * (m * bflo(r.z)); o[5] += cw.w[tap][5] * (m * bfhi(r.z)); o[6] += cw.w[tap][6] * (m * bflo(r.w)); o[7] += cw.w[tap][7] * (m * bfhi(r.w)); }
#pragma unroll
    for (int j = 0; j < 8; ++j) o[j] = pg8::silu(o[j]);
    return (v4u){pk2(o[0], o[1]), pk2(o[2], o[3]), pk2(o[4], o[5]), pk2(o[6], o[7])};
}

template <int NT> __device__ __forceinline__ void conv_win(const bf16* xb_, int t_first, int col0, const ConvW& cw, v4u (&out)[NT]) {
    v4u r[NT + 4];
#pragma unroll
    for (int i = 0; i < NT + 4; ++i) { const int tt = t_first - 2 + i; const bool ok = (tt >= 0) && (tt < SEQ); const int tc = ok ? tt : t_first;
        const v4u v = *(const v4u*)(xb_ + (size_t)tc * CONVCH + col0); r[i] = ok ? v : (v4u){0u, 0u, 0u, 0u}; }
#pragma unroll
    for (int n = 0; n < NT; ++n) { float o[8];
#pragma unroll
        for (int j = 0; j < 8; ++j) o[j] = cw.b[j];
#pragma unroll
        for (int tap = 0; tap < 5; ++tap) { const v4u x = r[n + tap];
            o[0] += cw.w[tap][0] * bflo(x.x); o[1] += cw.w[tap][1] * bfhi(x.x); o[2] += cw.w[tap][2] * bflo(x.y); o[3] += cw.w[tap][3] * bfhi(x.y);
            o[4] += cw.w[tap][4] * bflo(x.z); o[5] += cw.w[tap][5] * bfhi(x.z); o[6] += cw.w[tap][6] * bflo(x.w); o[7] += cw.w[tap][7] * bfhi(x.w); }
#pragma unroll
        for (int j = 0; j < 8; ++j) o[j] = pg8::silu(o[j]);
        out[n] = (v4u){pk2(o[0], o[1]), pk2(o[2], o[3]), pk2(o[4], o[5]), pk2(o[6], o[7])}; }
}

constexpr int ST_HEAD_BYTES = 16384;
__device__ __forceinline__ size_t st_off(int dir, int b, int c, int hg) { return ((((size_t)(dir * 2 + b) * NCHUNK + c) * NHEAD + hg) * ST_HEAD_BYTES); }
__device__ __forceinline__ void p2b_states(Frame& F) {
    const int lane = F.lane, fr = lane & 15, fq = lane >> 4, w = F.wave;
    LAS unsigned char* BMi = F.lds;
    LAS unsigned char* XS = F.lds + 34816 + w * 6144;
    LAS float* TAB = (LAS float*)(F.lds + 34816 + 8 * 6144 + w * 1024);
    for (int it = F.bid; it < 512; it += F.G) {
        const int g = it & 3, c = (it >> 2) & 63, b = it >> 8, t0 = c * CHUNK, hg = g * 8 + w;
        const bf16* xb_ = F.XBC() + (size_t)b * SEQ * CONVCH;
        {
            const int chunk = F.tid & 15, col0 = 2048 + g * 128 + chunk * 8, tb = (F.tid >> 4) * 4; ConvW cw; conv_load_w(cw, F.conv_w(), F.conv_b(), col0);
            v4u o4[4]; conv_win<4>(xb_, t0 + tb, col0, cw, o4);
#pragma unroll
            for (int i = 0; i < 4; ++i) *(LAS v4u*)(BMi + (tb + i) * 272 + chunk * 16) = o4[i];
        }
        {
            const float* dtp = F.DT() + (size_t)(b * SEQ + t0) * 64;
            const float df0 = dtp[lane * 64 + hg], df1 = dtp[(lane + 64) * 64 + hg], db0 = dtp[lane * 64 + 32 + hg], db1 = dtp[(lane + 64) * 64 + 32 + hg];
            const float Af = -__expf(F.alog_f()[hg]) * LOG2E, Ab = -__expf(F.alog_b()[hg]) * LOG2E;
            const float af0 = df0 * Af, af1 = df1 * Af, ab0 = db0 * Ab, ab1 = db1 * Ab;
            const float sf0 = wave_incl_scan(af0, lane), tf0 = __shfl(sf0, 63), sf1 = wave_incl_scan(af1, lane) + tf0, totf = __shfl(sf1, 63);
            const float sb0 = wave_incl_scan(ab0, lane), tb0 = __shfl(sb0, 63), sb1 = wave_incl_scan(ab1, lane) + tb0, totb = __shfl(sb1, 63);
            const float cb0 = totb - (sb0 - ab0), cb1 = totb - (sb1 - ab1);
            TAB[lane] = ex2(totf - sf0) * df0; TAB[64 + lane] = ex2(totf - sf1) * df1;
            TAB[128 + lane] = ex2(totb - cb0) * db0; TAB[192 + lane] = ex2(totb - cb1) * db1;
            if (lane == 0) { F.DEC()[((0 * 2 + b) * NCHUNK + c) * NHEAD + hg] = ex2(totf); F.DEC()[((1 * 2 + b) * NCHUNK + c) * NHEAD + hg] = ex2(totb); }
        }
        __syncthreads();
        for (int q = 0; q < 4; ++q) {
            {   const int chunk = lane & 1, col0 = g * 512 + w * 64 + q * 16 + chunk * 8, tb = (lane >> 1) * 4; ConvW cw; conv_load_w(cw, F.conv_w(), F.conv_b(), col0);
                v4u o4[4]; conv_win<4>(xb_, t0 + tb, col0, cw, o4);
#pragma unroll
                for (int i = 0; i < 4; ++i) *(LAS v4u*)(XS + (tb + i) * 48 + chunk * 16) = o4[i]; }
            {
                unsigned char* xd = F.XSF() + ((((size_t)(b * NCHUNK + c) * NHEAD + hg) * 16 + q * 4) * 64 + lane) * 16;
#pragma unroll
                for (int ks = 0; ks < 4; ++ks) *(v4u*)(xd + ks * 1024) = __builtin_bit_cast(v4u, frag_tr(XS, 48, 32 * ks + 4 * fq, 32 * ks + 16 + 4 * fq, 0, fr)); }
#pragma unroll
            for (int dir = 0; dir < 2; ++dir) {
                f32x4 acc[8];
#pragma unroll
                for (int mi = 0; mi < 8; ++mi) acc[mi] = (f32x4){0.f, 0.f, 0.f, 0.f};
#pragma unroll
                for (int ks = 0; ks < 4; ++ks) {
                    const v4u xr = __builtin_bit_cast(v4u, frag_tr(XS, 48, 32 * ks + 8 * fq, 32 * ks + 8 * fq + 4, 0, fr));
                    const f32x4 w0 = *(const LAS f32x4*)(TAB + dir * 128 + 32 * ks + 8 * fq), w1 = *(const LAS f32x4*)(TAB + dir * 128 + 32 * ks + 8 * fq + 4);
                    const bf16x8 bs = mk8(pk2(bflo(xr.x) * w0[0], bfhi(xr.x) * w0[1]), pk2(bflo(xr.y) * w0[2], bfhi(xr.y) * w0[3]), pk2(bflo(xr.z) * w1[0], bfhi(xr.z) * w1[1]), pk2(bflo(xr.w) * w1[2], bfhi(xr.w) * w1[3]));
#pragma unroll
                    for (int mi = 0; mi < 8; ++mi) { const bf16x8 a = frag_tr(BMi, 272, 32 * ks + 8 * fq, 32 * ks + 8 * fq + 4, 16 * mi, fr); acc[mi] = MFMA16(a, bs, acc[mi]); }
                }
                unsigned char* dst = (unsigned char*)F.ST() + st_off(dir, b, c, hg) + (size_t)(q * 4 * 64 + lane) * 16;
#pragma unroll
                for (int k2 = 0; k2 < 4; ++k2)
                    *(v4u*)(dst + k2 * 1024) = (v4u){pk2(acc[2 * k2][0], acc[2 * k2][1]), pk2(acc[2 * k2][2], acc[2 * k2][3]), pk2(acc[2 * k2 + 1][0], acc[2 * k2 + 1][1]), pk2(acc[2 * k2 + 1][2], acc[2 * k2 + 1][3])};
            }
        }
        __syncthreads();
    }
}

__device__ __forceinline__ void p3a_fft2(Frame& F) {
    const int lane = F.lane, fr = lane & 15, fq = lane >> 4, w = F.wave;
    LAS unsigned char* TB = F.lds;
    LAS unsigned char* WM = F.lds + 73728;
    int g_loaded = -1;
    for (int id = F.bid; id < 1024; id += F.G) {
        const int g = id & 7, ka = (id >> 3) & 63, b = id >> 9;
        __syncthreads();
        if (g != g_loaded) {
#pragma unroll
            for (int i = 0; i < 4; ++i) { const int u = F.tid + 512 * i, row = u >> 4, pc = u & 15; *(LAS v4u*)(WM + row * 272 + pc * 16) = *(const v4u*)(F.WMIX() + (size_t)g * 16384 + row * 128 + pc * 8); }
            g_loaded = g;
        }
        const bf16* src = F.TP() + ((size_t)(b * 64 + ka) * 8 + g) * 32768;
#pragma unroll
        for (int i = 0; i < 8; ++i) { const int u = F.tid + 512 * i, row = u >> 4, pc = u & 15; *(LAS v4u*)(TB + row * 288 + pc * 16) = *(const v4u*)(src + row * 128 + pc * 8); }
        __syncthreads();
        f32x4 d1[8];
#pragma unroll
        for (int ci = 0; ci < 8; ++ci) d1[ci] = (f32x4){0.f, 0.f, 0.f, 0.f};
#pragma unroll
        for (int ks = 0; ks < 8; ++ks) { const bf16x8 b1 = *(const bf16x8*)(F.W3() + (16 * w + fr) * 256 + 32 * ks + 8 * fq);
#pragma unroll
            for (int ci = 0; ci < 8; ++ci) { const bf16x8 a1 = frag_tr(TB, 288, 32 * ks + 8 * fq, 32 * ks + 8 * fq + 4, 16 * ci, fr); d1[ci] = MFMA16(a1, b1, d1[ci]); } }
        f32x4 d2[8];
#pragma unroll
        for (int oi = 0; oi < 8; ++oi) d2[oi] = (f32x4){0.f, 0.f, 0.f, 0.f};
#pragma unroll
        for (int k2 = 0; k2 < 4; ++k2) { const bf16x8 bf = mk8(pk2(d1[2 * k2][0], d1[2 * k2][1]), pk2(d1[2 * k2][2], d1[2 * k2][3]), pk2(d1[2 * k2 + 1][0], d1[2 * k2 + 1][1]), pk2(d1[2 * k2 + 1][2], d1[2 * k2 + 1][3]));
#pragma unroll
            for (int oi = 0; oi < 8; ++oi) { const LAS unsigned char* wp = WM + (16 * oi + fr) * 272 + (32 * k2 + 4 * fq) * 2; const v2u lo = *(const LAS v2u*)wp, hi = *(const LAS v2u*)(wp + 32);
                d2[oi] = MFMA16(mk8(lo.x, lo.y, hi.x, hi.y), bf, d2[oi]); } }
        const size_t token = (size_t)b * SEQ + ka + 64 * (16 * w + fr);
#pragma unroll
        for (int oi = 0; oi < 8; ++oi) { const int col = g * 128 + 16 * oi + 4 * fq; const f32x4 bias = *(const f32x4*)(F.fmix_b() + col); const v2u sz = *(const v2u*)(F.SZF() + token * FW + col);
            *(v2u*)(F.YPK() + token * FW + col) = (v2u){pk2((d2[oi][0] + bias[0]) * bflo(sz.x), (d2[oi][1] + bias[1]) * bfhi(sz.x)), pk2((d2[oi][2] + bias[2]) * bflo(sz.y), (d2[oi][3] + bias[3]) * bfhi(sz.y))}; }
    }
    __syncthreads();
}

__device__ __forceinline__ void p3b_scan(Frame& F) {
    for (int gid = F.bid * 512 + F.tid; gid < 131072; gid += F.G * 512) {
        const int unit = gid & 1023, h = (gid >> 10) & 31, b = (gid >> 15) & 1, dir = gid >> 16;
        float cr[8];
#pragma unroll
        for (int j = 0; j < 8; ++j) cr[j] = 0.f;
        for (int cb = 0; cb < NCHUNK; cb += 8) {
            v4u v[8]; float dc[8];
#pragma unroll
            for (int u = 0; u < 8; ++u) { const int c = dir ? (NCHUNK - 1 - (cb + u)) : (cb + u);
                v[u] = *(const v4u*)((const unsigned char*)F.ST() + st_off(dir, b, c, h) + (size_t)unit * 16); dc[u] = F.DEC()[((dir * 2 + b) * NCHUNK + c) * NHEAD + h]; }
#pragma unroll
            for (int u = 0; u < 8; ++u) { const int c = dir ? (NCHUNK - 1 - (cb + u)) : (cb + u);
                *(v4u*)((unsigned char*)F.ST() + st_off(dir, b, c, h) + (size_t)unit * 16) = (v4u){pk2(cr[0], cr[1]), pk2(cr[2], cr[3]), pk2(cr[4], cr[5]), pk2(cr[6], cr[7])};
                cr[0] = cr[0] * dc[u] + bflo(v[u].x); cr[1] = cr[1] * dc[u] + bfhi(v[u].x); cr[2] = cr[2] * dc[u] + bflo(v[u].y); cr[3] = cr[3] * dc[u] + bfhi(v[u].y);
                cr[4] = cr[4] * dc[u] + bflo(v[u].z); cr[5] = cr[5] * dc[u] + bfhi(v[u].z); cr[6] = cr[6] * dc[u] + bflo(v[u].w); cr[7] = cr[7] * dc[u] + bfhi(v[u].w); }
        }
    }
}

__device__ __forceinline__ void p4_ssd_out(Frame& F) {
    const int w = F.wave;
    LAS unsigned char* BMi = F.lds;
    LAS unsigned char* CMi = F.lds + 34816;
    LAS float* TAB = (LAS float*)(F.lds + 69632 + w * 2048);
    LAS float* SSQ = (LAS float*)(F.lds + 69632 + 16384);
    bf16* Y = F.TP();
#pragma unroll 1
    for (int it = F.bid; it < 512; it += F.G) {
        int lane_ = F.lane; asm volatile("" : "+v"(lane_));
        const int lane = lane_, fr = lane & 15, fq = lane >> 4;
        const int g = it & 3, c = (it >> 2) & 63, b = it >> 8, t0 = c * CHUNK, hg = g * 8 + w;
        const bf16* xb_ = F.XBC() + (size_t)b * SEQ * CONVCH;
        bf16x8 XSf[4][4];
        {   const unsigned char* xsrc = F.XSF() + (((size_t)(b * NCHUNK + c) * NHEAD + hg) * 16 * 64 + lane) * 16;
#pragma unroll
            for (int q = 0; q < 4; ++q)
#pragma unroll
                for (int ks = 0; ks < 4; ++ks) XSf[q][ks] = *(const bf16x8*)(xsrc + (q * 4 + ks) * 1024); }
        {
            const int chunk = F.tid & 31, isC = chunk >> 4, col0 = 2048 + isC * 512 + g * 128 + (chunk & 15) * 8, tb = (F.tid >> 5) * 8; ConvW cw; conv_load_w(cw, F.conv_w(), F.conv_b(), col0);
            LAS unsigned char* dst = (isC ? CMi : BMi) + (chunk & 15) * 16;
            v4u o8[8]; conv_win<8>(xb_, t0 + tb, col0, cw, o8);
#pragma unroll
            for (int i = 0; i < 8; ++i) *(LAS v4u*)(dst + (tb + i) * 272) = o8[i];
        }
        {
            const float* dtp = F.DT() + (size_t)(b * SEQ + t0) * 64;
            const float df0 = dtp[lane * 64 + hg], df1 = dtp[(lane + 64) * 64 + hg], db0 = dtp[lane * 64 + 32 + hg], db1 = dtp[(lane + 64) * 64 + 32 + hg];
            const float Af = -__expf(F.alog_f()[hg]) * LOG2E, Ab = -__expf(F.alog_b()[hg]) * LOG2E;
            const float af0 = df0 * Af, af1 = df1 * Af, ab0 = db0 * Ab, ab1 = db1 * Ab;
            const float sf0 = wave_incl_scan(af0, lane), tf0 = __shfl(sf0, 63), sf1 = wave_incl_scan(af1, lane) + tf0;
            const float sb0 = wave_incl_scan(ab0, lane), tb0 = __shfl(sb0, 63), sb1 = wave_incl_scan(ab1, lane) + tb0, totb = __shfl(sb1, 63);
            TAB[lane] = sf0; TAB[64 + lane] = sf1; TAB[128 + lane] = totb - (sb0 - ab0); TAB[192 + lane] = totb - (sb1 - ab1);
            TAB[256 + lane] = df0; TAB[320 + lane] = df1; TAB[384 + lane] = db0; TAB[448 + lane] = db1;
        }
        __syncthreads();
        {
            f32x4 d1[8];
#pragma unroll
            for (int si = 0; si < 8; ++si) d1[si] = (f32x4){0.f, 0.f, 0.f, 0.f};
#pragma unroll 1
            for (int ks = 0; ks < 4; ++ks) {
                const bf16x8 b1 = *(const LAS bf16x8*)(CMi + (16 * w + fr) * 272 + (32 * ks + 8 * fq) * 2);
#pragma unroll
                for (int si = 0; si < 8; ++si) { const bf16x8 a1 = *(const LAS bf16x8*)(BMi + (16 * si + fr) * 272 + (32 * ks + 8 * fq) * 2); d1[si] = MFMA16(a1, b1, d1[si]); }
            }
            __syncthreads();
#pragma unroll
            for (int si = 0; si < 8; ++si) *(LAS v2u*)(BMi + (16 * w + fr) * 272 + (16 * si + 4 * fq) * 2) = (v2u){pk2(d1[si][0], d1[si][1]), pk2(d1[si][2], d1[si][3])};
        }
        __syncthreads();
        const float dsk = F.d_skip()[hg];
        const int ntg = 4;
#pragma unroll 1
        for (int tg = 0; tg < ntg; ++tg) {
            int lane2_ = lane_; asm volatile("" : "+v"(lane2_));
            const int lane = lane2_, fr = lane & 15, fq = lane >> 4;
            const unsigned char* PF = (const unsigned char*)F.ST() + st_off(0, b, c, hg) + (size_t)lane * 16;
            const unsigned char* PB = (const unsigned char*)F.ST() + st_off(1, b, c, hg) + (size_t)lane * 16;
            const size_t tokA = (size_t)b * SEQ + t0 + 16 * (2 * tg) + fr, tokB = tokA + 16;
            v2u szr[4][2];
#pragma unroll
            for (int pi = 0; pi < 4; ++pi) { const int ch = hg * 64 + 16 * pi + 4 * fq; szr[pi][0] = *(const v2u*)(F.SZS() + tokA * SW + ch); szr[pi][1] = *(const v2u*)(F.SZS() + tokB * SW + ch); }
            bf16x8 Gf[2][4];
            {
                const int tA = 16 * (2 * tg) + fr, tB = tA + 16;
                const float cftA = TAB[tA], cbtA = TAB[128 + tA], cftB = TAB[tB], cbtB = TAB[128 + tB];
#pragma unroll
                for (int ks = 0; ks < 4; ++ks) { unsigned pkA[4], pkB[4];
#pragma unroll
                    for (int u = 0; u < 2; ++u) { const int si = 2 * ks + u;
                        const f32x4 cfs = *(const LAS f32x4*)(TAB + 16 * si + 4 * fq), cbs = *(const LAS f32x4*)(TAB + 128 + 16 * si + 4 * fq), dfs = *(const LAS f32x4*)(TAB + 256 + 16 * si + 4 * fq), dbs = *(const LAS f32x4*)(TAB + 384 + 16 * si + 4 * fq);
#pragma unroll
                        for (int tl = 0; tl < 2; ++tl) { const int t = tl ? tB : tA; const float cft = tl ? cftB : cftA, cbt = tl ? cbtB : cbtA; float gv[4];
                            const v2u cbr = *(const LAS v2u*)(BMi + t * 272 + (16 * si + 4 * fq) * 2); const float cbv[4] = {bflo(cbr.x), bfhi(cbr.x), bflo(cbr.y), bfhi(cbr.y)};
                            const int d0 = 16 * (si - 2 * tg - tl) + 4 * fq - fr;
#pragma unroll
                            for (int j = 0; j < 4; ++j) { const int d = d0 + j;
                                const float arg = (d < 0) ? (cft - cfs[j]) : (cbt - cbs[j]), sc = (d < 0) ? dfs[j] : dbs[j];
                                float e = ex2(fminf(arg, 0.f)) * sc; e = (d == 0) ? (dfs[j] + dbs[j]) : e;
                                gv[j] = cbv[j] * e + ((d == 0) ? dsk : 0.f); }
                            if (tl) { pkB[2 * u] = pk2(gv[0], gv[1]); pkB[2 * u + 1] = pk2(gv[2], gv[3]); } else { pkA[2 * u] = pk2(gv[0], gv[1]); pkA[2 * u + 1] = pk2(gv[2], gv[3]); } }
                    }
                    Gf[0][ks] = mk8(pkA[0], pkA[1], pkA[2], pkA[3]); Gf[1][ks] = mk8(pkB[0], pkB[1], pkB[2], pkB[3]);
                    __builtin_amdgcn_sched_barrier(0);
                }
            }
            __builtin_amdgcn_sched_barrier(0);
            f32x4 acc[4][2];
#pragma unroll
            for (int pi = 0; pi < 4; ++pi) { acc[pi][0] = (f32x4){0.f, 0.f, 0.f, 0.f}; acc[pi][1] = (f32x4){0.f, 0.f, 0.f, 0.f}; }
#pragma unroll
            for (int pi = 0; pi < 4; ++pi)
#pragma unroll
                for (int ks = 0; ks < 4; ++ks) { acc[pi][0] = MFMA16(XSf[pi][ks], Gf[0][ks], acc[pi][0]); acc[pi][1] = MFMA16(XSf[pi][ks], Gf[1][ks], acc[pi][1]); }
#pragma unroll
            for (int dir = 0; dir < 2; ++dir) {
                bf16x8 Cs[2][4];
#pragma unroll
                for (int tl = 0; tl < 2; ++tl) {
                    const int t = 16 * (2 * tg + tl) + fr; const float e = ex2(TAB[dir * 128 + t]);
#pragma unroll
                    for (int ks = 0; ks < 4; ++ks) {
                        const LAS unsigned char* cp = CMi + t * 272 + (32 * ks + 4 * fq) * 2; const v2u lo = *(const LAS v2u*)cp, hi = *(const LAS v2u*)(cp + 32);
                        Cs[tl][ks] = mk8(pk2(bflo(lo.x) * e, bfhi(lo.x) * e), pk2(bflo(lo.y) * e, bfhi(lo.y) * e), pk2(bflo(hi.x) * e, bfhi(hi.x) * e), pk2(bflo(hi.y) * e, bfhi(hi.y) * e));
                    }
                }
                const unsigned char* PS = dir ? PB : PF;
                bf16x8 st[4][4];
#pragma unroll
                for (int pi = 0; pi < 4; ++pi)
#pragma unroll
                    for (int ks = 0; ks < 4; ++ks) st[pi][ks] = *(const bf16x8*)(PS + (pi * 4 + ks) * 1024);
#pragma unroll
                for (int pi = 0; pi < 4; ++pi)
#pragma unroll
                    for (int ks = 0; ks < 4; ++ks) { acc[pi][0] = MFMA16(st[pi][ks], Cs[0][ks], acc[pi][0]); acc[pi][1] = MFMA16(st[pi][ks], Cs[1][ks], acc[pi][1]); }
                __builtin_amdgcn_sched_barrier(0);
            }
            float ssq0 = 0.f, ssq1 = 0.f;
#pragma unroll
            for (int pi = 0; pi < 4; ++pi) {
                acc[pi][0][0] *= bflo(szr[pi][0].x); acc[pi][0][1] *= bfhi(szr[pi][0].x); acc[pi][0][2] *= bflo(szr[pi][0].y); acc[pi][0][3] *= bfhi(szr[pi][0].y);
                acc[pi][1][0] *= bflo(szr[pi][1].x); acc[pi][1][1] *= bfhi(szr[pi][1].x); acc[pi][1][2] *= bflo(szr[pi][1].y); acc[pi][1][3] *= bfhi(szr[pi][1].y);
                ssq0 += (acc[pi][0][0] * acc[pi][0][0] + acc[pi][0][1] * acc[pi][0][1]) + (acc[pi][0][2] * acc[pi][0][2] + acc[pi][0][3] * acc[pi][0][3]);
                ssq1 += (acc[pi][1][0] * acc[pi][1][0] + acc[pi][1][1] * acc[pi][1][1]) + (acc[pi][1][2] * acc[pi][1][2] + acc[pi][1][3] * acc[pi][1][3]);
            }
            ssq0 += __shfl_xor(ssq0, 16); ssq0 += __shfl_xor(ssq0, 32); ssq1 += __shfl_xor(ssq1, 16); ssq1 += __shfl_xor(ssq1, 32);
            LAS float* sq = SSQ + (tg & 1) * 256;
            if (fq == 0) { sq[w * 32 + fr] = ssq0; sq[w * 32 + 16 + fr] = ssq1; }
            __syncthreads();
            float totA = 0.f, totB = 0.f;
#pragma unroll
            for (int ww = 0; ww < 8; ++ww) { totA += sq[ww * 32 + fr]; totB += sq[ww * 32 + 16 + fr]; }
            const float rsA = 1.0f / sqrtf(totA * (1.0f / 512.0f) + LN_EPS), rsB = 1.0f / sqrtf(totB * (1.0f / 512.0f) + LN_EPS);
#pragma unroll
            for (int pi = 0; pi < 4; ++pi) { const int ch = hg * 64 + 16 * pi + 4 * fq; const f32x4 nw = *(const f32x4*)(F.norm_w() + ch);
                *(v2u*)(Y + tokA * SW + ch) = (v2u){pk2(acc[pi][0][0] * rsA * nw[0], acc[pi][0][1] * rsA * nw[1]), pk2(acc[pi][0][2] * rsA * nw[2], acc[pi][0][3] * rsA * nw[3])};
                *(v2u*)(Y + tokB * SW + ch) = (v2u){pk2(acc[pi][1][0] * rsB * nw[0], acc[pi][1][1] * rsB * nw[1]), pk2(acc[pi][1][2] * rsB * nw[2], acc[pi][1][3] * rsB * nw[3])}; }
        }
        __syncthreads();
    }
}

__device__ __forceinline__ void p7_layernorm(Frame& F) {
    const int gw = F.bid * NWAVES + F.wave, NGW = F.G * NWAVES;
    for (int m = gw; m < M; m += NGW) {
        f32x4* xr = (f32x4*)(F.out + (size_t)m * DM) + F.lane;
        f32x4 v[8]; float s = 0.f;
#pragma unroll
        for (int j = 0; j < 8; ++j) { v[j] = xr[64 * j]; s += (v[j][0] + v[j][1]) + (v[j][2] + v[j][3]); }
        const float mean = wave_sum(s) * (1.0f / DM); float s2 = 0.f;
#pragma unroll
        for (int j = 0; j < 8; ++j) { v[j] = v[j] - mean; s2 += (v[j][0] * v[j][0] + v[j][1] * v[j][1]) + (v[j][2] * v[j][2] + v[j][3] * v[j][3]); }
        const float rstd = 1.0f / sqrtf(wave_sum(s2) * (1.0f / DM) + LN_EPS);
#pragma unroll
        for (int j = 0; j < 8; ++j) { const f32x4 gg = *((const f32x4*)F.ln_g() + F.lane + 64 * j), bb = *((const f32x4*)F.ln_b() + F.lane + 64 * j); xr[64 * j] = v[j] * rstd * gg + bb; }
    }
}

struct Args { const float* in[18]; float* out; unsigned char* ws; int ph_lo, ph_hi, variant, pad; };
__global__ void __launch_bounds__(NWAVES * 64, 2) hybrid_fwd(Args args) {
    extern __shared__ __attribute__((aligned(16))) unsigned char lds[];
    Frame F;
    F.lds = (LAS unsigned char*)lds;
    F.MISC = (volatile LAS unsigned*)(F.lds + MISC_OFF);
    F.tid = threadIdx.x; F.lane = F.tid & 63; F.wave = __builtin_amdgcn_readfirstlane(F.tid >> 6);
    F.G = gridDim.x; F.bid = blockIdx.x;
    unsigned char* ws = args.ws;
    F.ctl = (gu32*)(ws + WS_CTL);
    F.in = args.in; F.out = args.out; F.ws = ws; F.variant = args.variant;
    for (int u = F.tid; u < 64; u += NWAVES * 64) ((LAS unsigned*)(F.lds + MISC_OFF))[u] = 0u;
    __syncthreads();
    XcdBarrier bar = xcd_barrier_post((unsigned*)(F.ctl + CW_BAR), F.MISC + 8);
    const int lo = args.ph_lo, hi = args.ph_hi;
#ifndef PHASE_MASK
#define PHASE_MASK 0xFF
#endif
#define IN(k) (((PHASE_MASK >> (k)) & 1) && lo <= (k) && (k) < hi)
#define SEAM(k) do { if (IN(k) && IN((k) + 1)) xcd_barrier(bar); } while (0)
    if (IN(0)) { p0_prologue(F); } SEAM(0);
    if (IN(1)) {
        {
        pg8::Gemm gm{F.XB(), F.WIN(), M, N_P1, DM}; pg8::StaticOrder S; S.init(M, N_P1, F.G, F.bid);
        pg8::EpiInProj E{F.YPK(), F.SZF(), F.SZS(), F.XBC()};
        pg8::gemm_phase<pg8::EpiInProj, pg8::StaticOrder, true, true>(F.lds, gm, S, E);
        }
        p1b_dt(F);
    } SEAM(1);
    if (IN(2)) { { p2a_fft1(F); p2b_states(F); } } SEAM(2);
    if (IN(3)) { p3a_fft2(F); p3b_scan(F); } SEAM(3);
    if (IN(4)) { p4_ssd_out(F); } SEAM(4);
    if (IN(5)) {
        {
        bf16* S1 = F.XBC(); bf16* S2 = F.SZS(); bf16* Mb = F.XBC();
        pg8::StaticOrder S; S.init(M, DM, F.G, F.bid);
        { pg8::Gemm gm{F.XB(), F.WIN() + (size_t)COL_GATE * DM, M, DM, DM}; pg8::EpiGate E{S1, DM, F.b_gate()};
          pg8::gemm_phase<pg8::EpiGate, pg8::StaticOrder, true, true>(F.lds, gm, S, E); }
        { pg8::Gemm gm{F.YPK(), F.WBF(), M, DM, FW}; pg8::EpiMul<0> E{S1, nullptr, nullptr, DM};
          pg8::gemm_phase<pg8::EpiMul<0>, pg8::StaticOrder, true, true>(F.lds, gm, S, E); }
        { pg8::Gemm gm{F.XB(), F.WIN() + (size_t)(COL_GATE + DM) * DM, M, DM, DM}; pg8::EpiGate E{S2, DM, F.b_gate() + DM};
          pg8::gemm_phase<pg8::EpiGate, pg8::StaticOrder, true, true>(F.lds, gm, S, E); }
        { pg8::Gemm gm{F.TP(), F.WBS(), M, DM, SW}; pg8::EpiMul<1> E{S1, S2, Mb, DM};
          pg8::gemm_phase<pg8::EpiMul<1>, pg8::StaticOrder, true, true>(F.lds, gm, S, E); }
        }
    } SEAM(5);
    if (IN(6)) {
        {
        pg8::Gemm gm{F.XBC(), F.WOUT(), M, DM, DM}; pg8::StaticOrder S; S.init(M, DM, F.G, F.bid);
        pg8::EpiOut E{F.out, F.x(), DM, DN_ALPHA};
        pg8::gemm_phase<pg8::EpiOut, pg8::StaticOrder, true, true>(F.lds, gm, S, E);
        }
    } SEAM(6);
    if (IN(7)) { p7_layernorm(F); }
#undef IN
#undef SEAM
}

#ifndef MK_CUTS
#define MK_CUTS 0
#endif
extern "C" void kernel_launch(void* const* d_in, const int* in_sizes, int n_in, void* d_out, int out_size, void* d_ws, size_t ws_size, hipStream_t stream) {
    static int grid = 0;
    if (grid == 0) {
        if (n_in != 18 || in_sizes[0] != M * DM || out_size != M * DM || ws_size < WS_END) { fprintf(stderr, "kernel_launch: unexpected shapes (n_in %d, in0 %d, out %d, ws %zu)\n", n_in, n_in > 0 ? in_sizes[0] : -1, out_size, ws_size); grid = -1; return; }
        int dev = 0, cus = 0, per_cu = 0;
        if (hipGetDevice(&dev) != hipSuccess || hipDeviceGetAttribute(&cus, hipDeviceAttributeMultiprocessorCount, dev) != hipSuccess) { grid = -1; return; }
        if (hipFuncSetAttribute((const void*)hybrid_fwd, hipFuncAttributeMaxDynamicSharedMemorySize, LDS_BYTES) != hipSuccess) { fprintf(stderr, "kernel_launch: hipFuncSetAttribute failed\n"); grid = -1; return; }
        if (hipOccupancyMaxActiveBlocksPerMultiprocessor(&per_cu, (const void*)hybrid_fwd, NWAVES * 64, LDS_BYTES) != hipSuccess || per_cu < 1) fprintf(stderr, "kernel_launch: occupancy query reports %d\n", per_cu);
        (void)hipGetLastError();
        grid = cus;
    }
    if (grid < 0) return;
    if (hipMemsetAsync((char*)d_ws + WS_CTL, 0, CTL_ZERO_BYTES, stream) != hipSuccess) { fprintf(stderr, "kernel_launch: memset failed\n"); return; }
    Args a{};
    for (int i = 0; i < 18; ++i) a.in[i] = (const float*)d_in[i];
    a.out = (float*)d_out; a.ws = (unsigned char*)d_ws;
#if MK_CUTS
#ifndef PROBE_DUP
#define PROBE_DUP -1
#endif
#ifndef PROBE_VARIANT
#define PROBE_VARIANT 0
#endif
    for (int p = 0; p < 8; ++p) { a.ph_lo = p; a.ph_hi = p + 1;
        if (p == PROBE_DUP) { a.variant = PROBE_VARIANT; hipLaunchKernelGGL(hybrid_fwd, dim3(grid), dim3(NWAVES * 64), LDS_BYTES, stream, a); a.variant = 0; }
        hipLaunchKernelGGL(hybrid_fwd, dim3(grid), dim3(NWAVES * 64), LDS_BYTES, stream, a); }
#else
    a.ph_lo = 0; a.ph_hi = 8;
    hipLaunchKernelGGL(hybrid_fwd, dim3(grid), dim3(NWAVES * 64), LDS_BYTES, stream, a);
#endif
    const hipError_t le = hipPeekAtLastError();
    if (le != hipSuccess) fprintf(stderr, "kernel_launch: launch failed: %s\n", hipGetErrorName(le));
}
```
